# Optimizing an MI355X kernel written in HIP

```python
import math
import jax, jax.numpy as jnp
from jax import lax
import numpy as np

D_MODEL = 2048
BATCH = 4
SEQ = 4096
DEPTH = 1

HEAD_DIM = 128
SB_HEADS = 8
NSA_HEADS = 8
NSA_KV_GROUPS = 2
NSA_HPG = NSA_HEADS // NSA_KV_GROUPS
CMP_BLOCK = 32
CMP_STRIDE = 16
SLC_BLOCK = 64
N_SELECT = 16
WINDOW = 512
Q_BLOCK = 128
SLC_Q_BLOCK = 64
D_FF = 5632
NORM_EPS = 1e-6
NEG_INF = -1e30
FORCED_SCORE = 1e9

IN_SIZES = ([SB_HEADS * HEAD_DIM] * 3 + [NSA_HEADS * HEAD_DIM]
            + [NSA_KV_GROUPS * HEAD_DIM] * 6 + [3 * NSA_HEADS, 2 * D_MODEL])
IN_COLS = sum(IN_SIZES)

kernel_name = "hybrid_stickbreaking_nsa_macaron_block"


def rmsnorm(x, g):
    xf = x.astype(jnp.float32)
    y = xf * lax.rsqrt(jnp.mean(xf * xf, axis=-1, keepdims=True) + NORM_EPS)
    return (y * g.astype(jnp.float32)).astype(x.dtype)


def swiglu_ffn(h, w_in, w_out):
    gate, up = jnp.split(h @ w_in, 2, axis=-1)
    return (jax.nn.silu(gate) * up) @ w_out


def alibi_slopes(n):
    return jnp.asarray(2.0 ** (-8.0 * np.arange(1, n + 1) / n), jnp.float32)


def stick_breaking_attention(q, k, v):
    B, S, H, dh = q.shape
    f32 = jnp.float32
    scale = dh ** -0.5
    qf = jnp.transpose(q, (0, 2, 1, 3)).astype(f32)
    kf = jnp.transpose(k, (0, 2, 1, 3)).astype(f32)
    vf = jnp.transpose(v, (0, 2, 1, 3)).astype(f32)
    key_pos = jnp.arange(S)
    n_blocks = S // Q_BLOCK

    def block(i):
        start = i * Q_BLOCK
        qb = lax.dynamic_slice_in_dim(qf, start, Q_BLOCK, axis=2)
        z = jnp.einsum('bhqd,bhkd->bhqk', qb, kf) * scale
        q_pos = start + jnp.arange(Q_BLOCK)
        past = key_pos[None, :] < q_pos[:, None]
        log_beta = jax.nn.log_sigmoid(z)
        log_1m = jnp.where(past, jax.nn.log_sigmoid(-z), 0.0)
        suffix = lax.cumsum(log_1m, axis=3, reverse=True)
        weight = jnp.where(past, jnp.exp(log_beta + suffix - log_1m), 0.0)
        return jnp.einsum('bhqk,bhkd->bhqd', weight, vf)

    out = lax.map(block, jnp.arange(n_blocks))
    out = jnp.transpose(out, (1, 0, 3, 2, 4)).reshape(B, S, H * dh)
    return out


def compress_blocks(kv, pos, w1, w2):
    B, S, G, dh = kv.shape
    n_cmp = (S - CMP_BLOCK) // CMP_STRIDE + 1
    idx = np.arange(n_cmp)[:, None] * CMP_STRIDE + np.arange(CMP_BLOCK)[None, :]
    blocks = kv[:, idx] + pos[None, None, :, None, :]
    blocks = jnp.transpose(blocks, (0, 1, 3, 2, 4)).reshape(B, n_cmp, G, CMP_BLOCK * dh)
    return jax.nn.gelu(blocks @ w1) @ w2


def nsa_attention(q, k_cmp, v_cmp, k_slc, v_slc, k_win, v_win, gate_logits,
                  cmp_pos_k, cmp_k_w1, cmp_k_w2, cmp_pos_v, cmp_v_w1, cmp_v_w2):
    B, S, G, R, dh = q.shape
    f32 = jnp.float32
    scale = dh ** -0.5
    slopes = alibi_slopes(G * R).reshape(G, R)
    qf = q.astype(f32)
    t = np.arange(S)

    kc = compress_blocks(k_cmp.astype(f32), cmp_pos_k, cmp_k_w1, cmp_k_w2)
    vc = compress_blocks(v_cmp.astype(f32), cmp_pos_v, cmp_v_w1, cmp_v_w2)
    n_cmp = kc.shape[1]
    cmp_end = np.arange(n_cmp) * CMP_STRIDE + CMP_BLOCK - 1
    dist_c_np = t[:, None] - cmp_end[None, :]
    dist_c = jnp.asarray(dist_c_np, f32)
    valid_c = jnp.asarray(dist_c_np >= 0)
    s_c = (jnp.einsum('bqgrd,bkgd->bgrqk', qf, kc) * scale
           - slopes[None, :, :, None, None] * dist_c)
    p_cmp = jax.nn.softmax(jnp.where(valid_c, s_c, NEG_INF), axis=-1) * valid_c
    o_cmp = jnp.einsum('bgrqk,bkgd->bqgrd', p_cmp, vc)

    ratio = SLC_BLOCK // CMP_STRIDE
    span = CMP_BLOCK // CMP_STRIDE
    n_slc = S // SLC_BLOCK
    p_grp = jnp.sum(p_cmp, axis=2)
    need = ratio * (n_slc - 1) + (ratio - 1) + (span - 1) + 1
    p_pad = jnp.pad(p_grp, ((0, 0), (0, 0), (0, 0), (0, max(need - n_cmp, 0))))
    terms = [p_pad[..., m + n: m + n + ratio * (n_slc - 1) + 1: ratio]
             for m in range(ratio) for n in range(span)]
    slc_score = jnp.sum(jnp.stack(terms, axis=0), axis=0)
    blk = np.arange(n_slc)
    cur = t // SLC_BLOCK
    forced = (blk[None, :] == 0) | (blk[None, :] == cur[:, None]) | (blk[None, :] == cur[:, None] - 1)
    valid_blk = blk[None, :] * SLC_BLOCK <= t[:, None]
    slc_score = jnp.where(jnp.asarray(forced), FORCED_SCORE, slc_score)
    slc_score = jnp.where(jnp.asarray(valid_blk), slc_score, NEG_INF)
    n_top = min(N_SELECT, n_slc)
    _, sel_idx = lax.top_k(slc_score, n_top)

    kb = jnp.transpose(k_slc.astype(f32), (0, 2, 1, 3)).reshape(B, G, n_slc, SLC_BLOCK, dh)
    vb = jnp.transpose(v_slc.astype(f32), (0, 2, 1, 3)).reshape(B, G, n_slc, SLC_BLOCK, dh)
    bi = jnp.arange(B)[:, None, None, None]
    gi = jnp.arange(G)[None, :, None, None]
    in_blk = jnp.arange(SLC_BLOCK)

    def slc_block(i):
        start = i * SLC_Q_BLOCK
        qb = lax.dynamic_slice_in_dim(qf, start, SLC_Q_BLOCK, axis=1)
        ib = lax.dynamic_slice_in_dim(sel_idx, start, SLC_Q_BLOCK, axis=2)
        kg = kb[bi, gi, ib].reshape(B, G, SLC_Q_BLOCK, n_top * SLC_BLOCK, dh)
        vg = vb[bi, gi, ib].reshape(B, G, SLC_Q_BLOCK, n_top * SLC_BLOCK, dh)
        pos = (ib[..., None] * SLC_BLOCK + in_blk).reshape(B, G, SLC_Q_BLOCK, n_top * SLC_BLOCK)
        tq = start + jnp.arange(SLC_Q_BLOCK)
        dist = (tq[None, None, :, None] - pos)[:, :, None]
        s = (jnp.einsum('bqgrd,bgqkd->bgrqk', qb, kg) * scale
             - slopes[None, :, :, None, None] * dist.astype(f32))
        p = jax.nn.softmax(jnp.where(dist >= 0, s, NEG_INF), axis=-1)
        return jnp.einsum('bgrqk,bgqkd->bqgrd', p, vg)

    o_slc = lax.map(slc_block, jnp.arange(S // SLC_Q_BLOCK))
    o_slc = jnp.moveaxis(o_slc, 0, 1).reshape(B, S, G, R, dh)

    n_wb = S // Q_BLOCK
    kw_pad = jnp.pad(k_win.astype(f32), ((0, 0), (WINDOW, 0), (0, 0), (0, 0)))
    vw_pad = jnp.pad(v_win.astype(f32), ((0, 0), (WINDOW, 0), (0, 0), (0, 0)))
    widx = np.arange(n_wb)[:, None] * Q_BLOCK + np.arange(WINDOW + Q_BLOCK)[None, :]
    kwb = kw_pad[:, widx]
    vwb = vw_pad[:, widx]
    q_pos = np.arange(n_wb)[:, None] * Q_BLOCK + np.arange(Q_BLOCK)[None, :]
    k_pos = widx - WINDOW
    dist_w_np = q_pos[:, :, None] - k_pos[:, None, :]
    valid_w = jnp.asarray((dist_w_np >= 0) & (dist_w_np < WINDOW) & (k_pos[:, None, :] >= 0))
    dist_w = jnp.asarray(dist_w_np, f32)
    qwb = qf.reshape(B, n_wb, Q_BLOCK, G, R, dh)
    s_w = (jnp.einsum('bnqgrd,bnkgd->bgrnqk', qwb, kwb) * scale
           - slopes[None, :, :, None, None, None] * dist_w)
    p_w = jax.nn.softmax(jnp.where(valid_w, s_w, NEG_INF), axis=-1)
    o_win = jnp.einsum('bgrnqk,bnkgd->bnqgrd', p_w, vwb).reshape(B, S, G, R, dh)

    g = jax.nn.sigmoid(gate_logits.astype(f32)).reshape(B, S, 3, G, R, 1)
    out = g[:, :, 0] * o_cmp + g[:, :, 1] * o_slc + g[:, :, 2] * o_win
    return out.reshape(B, S, G * R * dh)


def hybrid_mixer(h, w_in, cmp_pos_k, cmp_k_w1, cmp_k_w2, cmp_pos_v, cmp_v_w1, cmp_v_w2,
                 w_branch_sb, w_branch_nsa, w_out):
    B, S, _ = h.shape
    proj = h @ w_in
    offsets = np.cumsum(IN_SIZES)[:-1].tolist()
    (q_sb, k_sb, v_sb, q_nsa, k_cmp, v_cmp, k_slc, v_slc, k_win, v_win,
     nsa_gates, merge_logits) = jnp.split(proj, offsets, axis=-1)
    heads = lambda a, n: a.reshape(B, S, n, HEAD_DIM)
    sb_out = stick_breaking_attention(heads(q_sb, SB_HEADS), heads(k_sb, SB_HEADS),
                                      heads(v_sb, SB_HEADS)).astype(h.dtype)
    G = NSA_KV_GROUPS
    nsa_out = nsa_attention(q_nsa.reshape(B, S, G, NSA_HPG, HEAD_DIM),
                            heads(k_cmp, G), heads(v_cmp, G), heads(k_slc, G), heads(v_slc, G),
                            heads(k_win, G), heads(v_win, G), nsa_gates,
                            cmp_pos_k, cmp_k_w1, cmp_k_w2, cmp_pos_v, cmp_v_w1, cmp_v_w2).astype(h.dtype)
    y_sb = sb_out @ w_branch_sb
    y_nsa = nsa_out @ w_branch_nsa
    gates = jax.nn.sigmoid(merge_logits.astype(jnp.float32)).reshape(B, S, 2, D_MODEL).astype(h.dtype)
    merged = gates[:, :, 0] * y_sb + gates[:, :, 1] * y_nsa
    return merged @ w_out


def setup_inputs(seed: int = 0) -> dict:
    key = jax.random.key(seed)
    ks = jax.random.split(key, 22)
    f32 = jnp.float32
    L = DEPTH
    dense = lambda k, shape, fan_in: jax.random.normal(k, shape, f32) * fan_in ** -0.5
    gain = lambda k: 1.0 + 0.02 * jax.random.normal(k, (L, D_MODEL), f32)
    return {
        "x": jax.random.normal(ks[0], (BATCH, SEQ, D_MODEL), f32),
        "ffn1_pre_g": gain(ks[1]),
        "ffn1_w_in": dense(ks[2], (L, D_MODEL, 2 * D_FF), D_MODEL),
        "ffn1_w_out": dense(ks[3], (L, D_FF, D_MODEL), D_FF),
        "ffn1_post_g": gain(ks[4]),
        "mix_pre_g": gain(ks[5]),
        "w_in": dense(ks[6], (L, D_MODEL, IN_COLS), D_MODEL),
        "cmp_pos_k": 0.02 * jax.random.normal(ks[7], (L, CMP_BLOCK, HEAD_DIM), f32),
        "cmp_k_w1": dense(ks[8], (L, CMP_BLOCK * HEAD_DIM, HEAD_DIM), CMP_BLOCK * HEAD_DIM),
        "cmp_k_w2": dense(ks[9], (L, HEAD_DIM, HEAD_DIM), HEAD_DIM),
        "cmp_pos_v": 0.02 * jax.random.normal(ks[10], (L, CMP_BLOCK, HEAD_DIM), f32),
        "cmp_v_w1": dense(ks[11], (L, CMP_BLOCK * HEAD_DIM, HEAD_DIM), CMP_BLOCK * HEAD_DIM),
        "cmp_v_w2": dense(ks[12], (L, HEAD_DIM, HEAD_DIM), HEAD_DIM),
        "w_branch_sb": dense(ks[13], (L, SB_HEADS * HEAD_DIM, D_MODEL), SB_HEADS * HEAD_DIM),
        "w_branch_nsa": dense(ks[14], (L, NSA_HEADS * HEAD_DIM, D_MODEL), NSA_HEADS * HEAD_DIM),
        "w_out": dense(ks[15], (L, D_MODEL, D_MODEL), D_MODEL),
        "mix_post_g": gain(ks[16]),
        "ffn2_pre_g": gain(ks[17]),
        "ffn2_w_in": dense(ks[18], (L, D_MODEL, 2 * D_FF), D_MODEL),
        "ffn2_w_out": dense(ks[19], (L, D_FF, D_MODEL), D_FF),
        "ffn2_post_g": gain(ks[20]),
    }


def reference(x, ffn1_pre_g, ffn1_w_in, ffn1_w_out, ffn1_post_g, mix_pre_g, w_in,
              cmp_pos_k, cmp_k_w1, cmp_k_w2, cmp_pos_v, cmp_v_w1, cmp_v_w2,
              w_branch_sb, w_branch_nsa, w_out, mix_post_g,
              ffn2_pre_g, ffn2_w_in, ffn2_w_out, ffn2_post_g):
    for l in range(DEPTH):
        h = rmsnorm(x, ffn1_pre_g[l])
        x = x + 0.5 * rmsnorm(swiglu_ffn(h, ffn1_w_in[l], ffn1_w_out[l]), ffn1_post_g[l])
        h = rmsnorm(x, mix_pre_g[l])
        y = hybrid_mixer(h, w_in[l], cmp_pos_k[l], cmp_k_w1[l], cmp_k_w2[l],
                         cmp_pos_v[l], cmp_v_w1[l], cmp_v_w2[l],
                         w_branch_sb[l], w_branch_nsa[l], w_out[l])
        x = x + rmsnorm(y, mix_post_g[l])
        h = rmsnorm(x, ffn2_pre_g[l])
        x = x + 0.5 * rmsnorm(swiglu_ffn(h, ffn2_w_in[l], ffn2_w_out[l]), ffn2_post_g[l])
    return x
```

```cpp
#include <hip/hip_runtime.h>
#include <hip/hip_cooperative_groups.h>
#include <cstdio>
namespace cg = cooperative_groups;
namespace pg8 {
#define PG8_LAS __attribute__((address_space(3)))
typedef unsigned short bf16_t;
typedef short bf16x8 __attribute__((ext_vector_type(8)));
typedef float f32x4 __attribute__((ext_vector_type(4)));
typedef unsigned u32x4 __attribute__((ext_vector_type(4)));
constexpr int BM = 256, BK = 64, HALF = 128, HTB = HALF * BK * 2  , STAGE_BYTES = 8 * HTB, NXCD = 8, WGM = 8;

__host__ __device__ __forceinline__ int lds_byte(int r, int c) { const int st = (r >> 4) * 2 + (c >> 5), rr = r & 15, cc = c & 31, ob = rr * 64 + cc * 2; return st * 1024 + (ob ^ (((ob >> 9) & 1) << 5)); }
__host__ __device__ __forceinline__ void stage_rc(int b, int& R, int& C) { const int st = b / 1024, sb = b % 1024, swz = sb ^ (((sb >> 9) & 1) << 5); R = (st >> 1) * 16 + swz / 64; C = (st & 1) * 32 + (swz % 64) / 2; }
__host__ __device__ __forceinline__ int perm32(int rho) { const int n = rho >> 4, i = rho & 15; return 8 * (i >> 2) + 4 * n + (i & 3); }

struct Unit { int pm, pn; };
struct Gemm { const bf16_t* A; const bf16_t* Bt; int M, N, K, lda; };

struct StaticOrder {
    int nM, nN, nwg, G, c;
    __host__ __device__ void init(int M, int N, int G_, int c_) { nM = M / BM; nN = N / BM; nwg = nM * nN; G = G_; c = c_; }
    __host__ __device__ bool next(int i, Unit& u) const {
        const long L = (long)i * G + c; if (L >= nwg) return false;
        int wgid = (int)L; { const int q = nwg / NXCD, r = nwg % NXCD, xcd = wgid % NXCD, off = wgid / NXCD; wgid = (xcd < r ? xcd * (q + 1) : r * (q + 1) + (xcd - r) * q) + off; }
        const int nig = WGM * nN, gid = wgid / nig, fm = gid * WGM, gsz = (nM - fm) < WGM ? (nM - fm) : WGM;
        u.pm = fm + ((wgid % nig) % gsz); u.pn = (wgid % nig) / gsz; return true;
    }
    __device__ __forceinline__ void a_ready(const Unit&) const {}
    __device__ __forceinline__ void done(const Unit&) const {}
};
struct CountedOrder : StaticOrder {
    const unsigned* ready; unsigned need; unsigned* tmo;
    __device__ __forceinline__ void a_ready(const Unit& u) const {
        if (threadIdx.x < 64) {
            const unsigned long long t0 = __builtin_amdgcn_s_memrealtime(); unsigned polls = 0;
            while ((unsigned)__builtin_amdgcn_readfirstlane(__hip_atomic_load(ready + 64 * u.pm, __ATOMIC_RELAXED, __HIP_MEMORY_SCOPE_AGENT)) < need) {
                if ((++polls & 255u) == 0u && __builtin_amdgcn_readfirstlane(__hip_atomic_load(tmo, __ATOMIC_RELAXED, __HIP_MEMORY_SCOPE_AGENT)) != 0u) break;
                if (__builtin_amdgcn_s_memrealtime() - t0 > 2000000ull) {
                    if (threadIdx.x == 0) { unsigned expect = 0u; __hip_atomic_compare_exchange_strong(tmo + 1, &expect, 0x600u | (unsigned)(u.pm & 0xff), __ATOMIC_RELAXED, __ATOMIC_RELAXED, __HIP_MEMORY_SCOPE_AGENT); __hip_atomic_store(tmo, 1u, __ATOMIC_RELAXED, __HIP_MEMORY_SCOPE_AGENT); }
                    break; }
                __builtin_amdgcn_s_sleep(2); }
            __builtin_amdgcn_fence(__ATOMIC_ACQUIRE, "agent");
            asm volatile("s_waitcnt vmcnt(0)" ::: "memory");
        }
#if !defined(BROKEN_HOOK_NO_BARRIER)
        asm volatile("" ::: "memory"); __builtin_amdgcn_s_barrier(); asm volatile("" ::: "memory");
#endif
    }
};

__device__ __forceinline__ unsigned cvt_pk_bf16(float lo, float hi) { unsigned r; asm volatile("v_cvt_pk_bf16_f32 %0, %1, %2" : "=v"(r) : "v"(lo), "v"(hi)); return r; }
typedef float f32x2 __attribute__((ext_vector_type(2)));
__device__ __forceinline__ f32x2 gelu_pk(f32x2 v) {
    const f32x2 av = __builtin_elementwise_abs(v), d = av * 0.2316418882f + 1.0f;
    f32x2 t; t.x = __builtin_amdgcn_rcpf(d.x); t.y = __builtin_amdgcn_rcpf(d.y);
    f32x2 q = t * 0.5307027145f + (-0.7265760135f); q = q * t + 0.7107068705f; q = q * t + (-0.142248368f); q = q * t + 0.127414796f; q = q * t;
    const f32x2 s = (v * v) * (-0.72134752044f);
    f32x2 e; e.x = __builtin_amdgcn_exp2f(s.x); e.y = __builtin_amdgcn_exp2f(s.y);
    const f32x2 m = v * (q * e), r = v - m;
    f32x2 o; o.x = v.x < 0.f ? m.x : r.x; o.y = v.y < 0.f ? m.y : r.y; return o;
}

struct EpiF32 {
    static constexpr bool PERM = false, AFTER_DRAIN = false;
    float* C; int ldc; const float* bias;
    __device__ __forceinline__ void operator()(const f32x4 (&acc)[2][2][4][2], const Unit& u, int wr, int wc, int fr, int fq) const {
        const int row0 = u.pm * BM + wr * 64 + fr, col0 = u.pn * BM + wc * 32 + 4 * fq;
        f32x4 bv[2][2];
#pragma unroll
        for (int bj = 0; bj < 2; ++bj)
#pragma unroll
            for (int n = 0; n < 2; ++n) bv[bj][n] = bias ? *(const f32x4*)(bias + col0 + bj * HALF + n * 16) : (f32x4){0.f, 0.f, 0.f, 0.f};
#pragma unroll
        for (int ai = 0; ai < 2; ++ai)
#pragma unroll
            for (int m = 0; m < 4; ++m) { float* rowp = C + (size_t)(row0 + ai * HALF + m * 16) * ldc + col0;
#pragma unroll
                for (int bj = 0; bj < 2; ++bj)
#pragma unroll
                    for (int n = 0; n < 2; ++n) *(f32x4*)(rowp + bj * HALF + n * 16) = acc[ai][bj][m][n] + bv[bj][n]; }
    }
};
template <int ACT  > struct EpiBf16 {
    static constexpr bool PERM = true, AFTER_DRAIN = false;
    bf16_t* O; int ldc; const float* bias; int split_cols; size_t split_stride;
    __device__ __forceinline__ void operator()(const f32x4 (&acc)[2][2][4][2], const Unit& u, int wr, int wc, int fr, int fq) const {
        const int row0 = u.pm * BM + wr * 64 + fr; int colt = u.pn * BM; bf16_t* base = O;
        if (split_cols) { const int t = colt / split_cols; base += (size_t)t * split_stride; colt -= t * split_cols; }
        const int col0 = colt + wc * 32 + 8 * fq, bcol0 = u.pn * BM + wc * 32 + 8 * fq;
        f32x4 bv[2][2];
#pragma unroll
        for (int bj = 0; bj < 2; ++bj)
#pragma unroll
            for (int n = 0; n < 2; ++n) bv[bj][n] = bias ? *(const f32x4*)(bias + bcol0 + bj * HALF + 4 * n) : (f32x4){0.f, 0.f, 0.f, 0.f};
#pragma unroll
        for (int ai = 0; ai < 2; ++ai)
#pragma unroll
            for (int m = 0; m < 4; ++m) { bf16_t* rowp = base + (size_t)(row0 + ai * HALF + m * 16) * ldc + col0;
#pragma unroll
                for (int bj = 0; bj < 2; ++bj) { f32x4 v0 = acc[ai][bj][m][0] + bv[bj][0], v1 = acc[ai][bj][m][1] + bv[bj][1];
                    if (ACT == 1) { f32x2 a = gelu_pk((f32x2){v0[0], v0[1]}), b = gelu_pk((f32x2){v0[2], v0[3]}), c = gelu_pk((f32x2){v1[0], v1[1]}), d = gelu_pk((f32x2){v1[2], v1[3]});
                        v0 = (f32x4){a.x, a.y, b.x, b.y}; v1 = (f32x4){c.x, c.y, d.x, d.y}; }
                    if (ACT == 2) {
#pragma unroll
                        for (int j = 0; j < 4; ++j) { v0[j] = 0.5f * v0[j] * (1.0f + erff(v0[j] * 0.70710678f)); v1[j] = 0.5f * v1[j] * (1.0f + erff(v1[j] * 0.70710678f)); } }
                    u32x4 w; w.x = cvt_pk_bf16(v0[0], v0[1]); w.y = cvt_pk_bf16(v0[2], v0[3]); w.z = cvt_pk_bf16(v1[0], v1[1]); w.w = cvt_pk_bf16(v1[2], v1[3]);
                    *(u32x4*)(rowp + bj * HALF) = w; } }
    }
};

template <class Epi, class Sched, bool STAMP = false>
__device__ __forceinline__ void gemm_phase(PG8_LAS unsigned char* lds, const Gemm g, const Sched& S, const Epi& E, unsigned long long* stamps) {
    const int tid = threadIdx.x, wid = __builtin_amdgcn_readfirstlane(tid >> 6), lane = tid & 63, wr = wid >> 2, wc = wid & 3, fr = lane & 15, fq = lane >> 4;
    const int K = g.K, nt = K / BK;
    int ts_lo = 0, ts_hi = 0, nts = 0; const unsigned long long rt_entry = STAMP ? (unsigned long long)wall_clock64() : 0ull;
#define PG8_STAMP() do { if (STAMP && wid == 0 && nts < 64) { const unsigned long long _c = (unsigned long long)clock64(); \
        ts_lo = (lane == nts) ? (int)(unsigned)_c : ts_lo; ts_hi = (lane == nts) ? (int)(unsigned)(_c >> 32) : ts_hi; ++nts; } } while (0)
    PG8_STAMP();
    unsigned voffA[2], voffB[2];
#pragma unroll
    for (int i = 0; i < 2; ++i) { int R, C; stage_rc(tid * 16 + i * 8192, R, C); const int Rb = Epi::PERM ? ((R & ~31) + perm32(R & 31)) : R;
        voffA[i] = (unsigned)(R * g.lda + C) * 2u; voffB[i] = (unsigned)(Rb * K + C) * 2u; }
    const size_t kstep = (size_t)(BK * 2);
    const size_t hstep = (size_t)HALF * K * 2;
    const size_t tstep = 2 * hstep; const size_t hstepA = (size_t)HALF * g.lda * 2; const size_t tstepA = 2 * hstepA;
    const unsigned ldsw = (unsigned)wid * 1024u;
    const int aoff = lds_byte(wr * 64 + fr, fq * 8), boff = lds_byte(wc * 32 + fr, fq * 8);
#define PG8_SA(b, h) (((b) * 2 + (h)) * HTB)
#define PG8_SB(b, h) ((4 + (b) * 2 + (h)) * HTB)
#define PG8_STAGE(bufoff, gbase, voff) do { _Pragma("unroll") for (int _i = 0; _i < 2; ++_i) \
        __builtin_amdgcn_global_load_lds((const unsigned*)((const char*)(gbase) + (voff)[_i]), (PG8_LAS unsigned*)(lds + (bufoff) + ldsw + _i * 8192), 16, 0, 0); } while (0)
#define PG8_LDA(dst, b, h) do { _Pragma("unroll") for (int m = 0; m < 4; ++m) _Pragma("unroll") for (int k = 0; k < 2; ++k) dst[m][k] = *(const PG8_LAS bf16x8*)(lds + PG8_SA(b, h) + aoff + m * 2048 + k * 1024); } while (0)
#define PG8_LDB(dst, b, h) do { _Pragma("unroll") for (int n = 0; n < 2; ++n) _Pragma("unroll") for (int k = 0; k < 2; ++k) dst[n][k] = *(const PG8_LAS bf16x8*)(lds + PG8_SB(b, h) + boff + n * 2048 + k * 1024); } while (0)
#define PG8_MMA(ai, bj, At, Bt) do { __builtin_amdgcn_s_setprio(1); _Pragma("unroll") for (int m = 0; m < 4; ++m) _Pragma("unroll") for (int n = 0; n < 2; ++n) _Pragma("unroll") for (int k = 0; k < 2; ++k) \
        acc[ai][bj][m][n] = __builtin_amdgcn_mfma_f32_16x16x32_bf16(Bt[n][k], At[m][k], acc[ai][bj][m][n], 0, 0, 0); __builtin_amdgcn_s_setprio(0); } while (0)
#define PG8_WAIT_V(n) asm volatile("s_waitcnt vmcnt(" #n ")" ::: "memory")
#define PG8_WAIT_L(n) asm volatile("s_waitcnt lgkmcnt(" #n ")" ::: "memory")
#define PG8_BAR __builtin_amdgcn_s_barrier()
#define PG8_SCHED __builtin_amdgcn_sched_barrier(0)
    Unit cur, nxt; int ui = 0;
    if (!S.next(0, cur)) return;
    f32x4 acc[2][2][4][2];
#pragma unroll
    for (int a = 0; a < 2; ++a)
#pragma unroll
        for (int b = 0; b < 2; ++b)
#pragma unroll
            for (int m = 0; m < 4; ++m)
#pragma unroll
                for (int n = 0; n < 2; ++n) acc[a][b][m][n] = (f32x4){0.f, 0.f, 0.f, 0.f};
    bf16x8 At[4][2], B0[2][2], B1[2][2];
    const char* cA = (const char*)g.A + (size_t)cur.pm * tstepA; const char* cB = (const char*)g.Bt + (size_t)cur.pn * tstep;
    S.a_ready(cur);
    PG8_STAGE(PG8_SB(0, 0), cB, voffB); PG8_STAGE(PG8_SA(0, 0), cA, voffA); PG8_STAGE(PG8_SB(0, 1), cB + hstep, voffB); PG8_STAGE(PG8_SA(0, 1), cA + hstepA, voffA);
    if (wr == 1) PG8_BAR;
    PG8_WAIT_V(4); PG8_BAR;
    PG8_STAGE(PG8_SB(1, 0), cB + kstep, voffB); PG8_STAGE(PG8_SA(1, 0), cA + kstep, voffA); PG8_STAGE(PG8_SB(1, 1), cB + hstep + kstep, voffB);
    PG8_WAIT_V(6); PG8_BAR;
    PG8_STAMP();
    for (;;) {
        const bool has_next = S.next(ui + 1, nxt);
        const char* nA = has_next ? (const char*)g.A + (size_t)nxt.pm * tstepA : cA; const char* nB = has_next ? (const char*)g.Bt + (size_t)nxt.pn * tstep : cB;
        for (int t = 0; t < nt; t += 2) {
            const bool last = (t == nt - 2);
            const char* a1 = cA + (size_t)(t + 1) * kstep;
            const char* a2 = last ? nA : cA + (size_t)(t + 2) * kstep; const char* b2 = last ? nB : cB + (size_t)(t + 2) * kstep;
            const char* a3 = a2 + kstep; const char* b3 = b2 + kstep;
            if (last && has_next) S.a_ready(nxt);
            PG8_LDB(B0, 0, 0); PG8_SCHED; PG8_LDA(At, 0, 0); PG8_STAGE(PG8_SA(1, 1), a1 + hstepA, voffA);
            PG8_WAIT_L(8); PG8_BAR; PG8_WAIT_L(0); PG8_MMA(0, 0, At, B0); PG8_BAR; PG8_SCHED;
            PG8_LDB(B1, 0, 1); PG8_STAGE(PG8_SB(0, 0), b2, voffB);
            PG8_BAR; PG8_WAIT_L(0); PG8_MMA(0, 1, At, B1); PG8_BAR;
            PG8_LDA(At, 0, 1); PG8_STAGE(PG8_SA(0, 0), a2, voffA);
            PG8_BAR; PG8_WAIT_L(0); PG8_MMA(1, 0, At, B0); PG8_BAR; PG8_SCHED;
            PG8_STAGE(PG8_SB(0, 1), b2 + hstep, voffB);
            PG8_WAIT_V(6); PG8_BAR; PG8_MMA(1, 1, At, B1); PG8_BAR;
            PG8_LDB(B0, 1, 0); PG8_SCHED; PG8_LDA(At, 1, 0); PG8_STAGE(PG8_SA(0, 1), a2 + hstepA, voffA);
            PG8_WAIT_L(8); PG8_BAR; PG8_WAIT_L(0); PG8_MMA(0, 0, At, B0); PG8_BAR; PG8_SCHED;
            PG8_LDB(B1, 1, 1); PG8_STAGE(PG8_SB(1, 0), b3, voffB);
            PG8_BAR; PG8_WAIT_L(0); PG8_MMA(0, 1, At, B1); PG8_BAR;
            PG8_LDA(At, 1, 1); PG8_STAGE(PG8_SA(1, 0), a3, voffA);
            PG8_BAR; PG8_WAIT_L(0); PG8_MMA(1, 0, At, B0); PG8_BAR; PG8_SCHED;
            PG8_STAGE(PG8_SB(1, 1), b3 + hstep, voffB);
            PG8_WAIT_V(6); PG8_BAR; PG8_MMA(1, 1, At, B1); PG8_BAR;
        }
        PG8_STAMP();
        if constexpr (!Epi::AFTER_DRAIN) { E(acc, cur, wr, wc, fr, fq); S.done(cur); }
        PG8_STAMP();
        if (!has_next) break;
#pragma unroll
        for (int a = 0; a < 2; ++a)
#pragma unroll
            for (int b = 0; b < 2; ++b)
#pragma unroll
                for (int m = 0; m < 4; ++m)
#pragma unroll
                    for (int n = 0; n < 2; ++n) acc[a][b][m][n] = (f32x4){0.f, 0.f, 0.f, 0.f};
        cur = nxt; cA = nA; cB = nB; ++ui;
    }
    PG8_WAIT_V(0);
    if (wr == 0) PG8_BAR;
    PG8_BAR;
    if constexpr (Epi::AFTER_DRAIN) { E.fused(acc, cur, wr, wc, fr, fq, lds, wid, lane); S.done(cur); }
    PG8_STAMP();
    if (STAMP && wid == 0) { stamps[lane] = lane < nts ? (((unsigned long long)(unsigned)ts_hi << 32) | (unsigned)ts_lo) : 0ull;
        if (lane == 62) stamps[62] = rt_entry; if (lane == 63) stamps[63] = (unsigned long long)wall_clock64(); }
#undef PG8_STAMP
#undef PG8_SA
#undef PG8_SB
#undef PG8_STAGE
#undef PG8_LDA
#undef PG8_LDB
#undef PG8_MMA
#undef PG8_WAIT_V
#undef PG8_WAIT_L
#undef PG8_BAR
#undef PG8_SCHED
}
}
namespace mk {
typedef unsigned short bf16_t;
typedef short bf16x8 __attribute__((ext_vector_type(8)));
typedef short s16x4 __attribute__((ext_vector_type(4)));
typedef float f32x16 __attribute__((ext_vector_type(16)));
typedef float f32x4 __attribute__((ext_vector_type(4)));
typedef unsigned u32x4 __attribute__((ext_vector_type(4)));
typedef unsigned u32x2 __attribute__((ext_vector_type(2)));
#define DI __device__ __forceinline__

constexpr int B_ = 4, S_ = 4096, T_ = B_ * S_, D_ = 2048, FF_ = 5632, NVIN = 9984;
constexpr int NTHREADS = 512;
constexpr float EPS = 1e-6f;
constexpr float LOG2E = 1.4426950408889634f;
constexpr float QSCALE = 0.08838834764831845f;

constexpr size_t al(size_t x) { return (x + 4095) & ~(size_t)4095; }
constexpr size_t WS_WFIN = 0;
constexpr size_t WS_WFOUT = WS_WFIN + al((size_t)2 * FF_ * D_ * 2);
constexpr size_t WS_WIN = WS_WFOUT + al((size_t)D_ * FF_ * 2);
constexpr size_t WS_WSB = WS_WIN + al((size_t)NVIN * D_ * 2);
constexpr size_t WS_WNSA = WS_WSB + al((size_t)D_ * 1024 * 2);
constexpr size_t WS_WOUT = WS_WNSA + al((size_t)D_ * 1024 * 2);
constexpr size_t WS_WC1K = WS_WOUT + al((size_t)D_ * D_ * 2);
constexpr size_t WS_WC1V = WS_WC1K + al((size_t)256 * 4096 * 2);
constexpr size_t WS_WC2K = WS_WC1V + al((size_t)256 * 4096 * 2);
constexpr size_t WS_WC2V = WS_WC2K + al((size_t)256 * 256 * 2);
constexpr size_t WS_BIAS = WS_WC2V + al((size_t)256 * 256 * 2);
constexpr size_t WS_H = WS_BIAS + 4096;
constexpr size_t WS_Y = WS_H + al((size_t)T_ * D_ * 2);
constexpr size_t WS_ACT = WS_Y + al((size_t)T_ * D_ * 4);
constexpr size_t WS_QSB = WS_ACT;
constexpr size_t WS_KSB = WS_QSB + (size_t)T_ * 1024 * 2;
constexpr size_t WS_VTSB = WS_KSB + (size_t)T_ * 1024 * 2;
constexpr size_t WS_QNSA = WS_VTSB + (size_t)T_ * 1024 * 2;
constexpr size_t WS_KCK = WS_QNSA + (size_t)T_ * 1024 * 2;
constexpr size_t WS_KCV = WS_KCK + (size_t)T_ * 256 * 2 + 65536;
constexpr size_t WS_KSLC = WS_KCV + (size_t)T_ * 256 * 2 + 65536;
constexpr size_t WS_VTSLC = WS_KSLC + (size_t)T_ * 256 * 2;
constexpr size_t WS_KWIN = WS_VTSLC + (size_t)T_ * 256 * 2;
constexpr size_t WS_VTWIN = WS_KWIN + (size_t)T_ * 256 * 2;
constexpr size_t WS_GN = WS_VTWIN + (size_t)T_ * 256 * 2;
constexpr size_t WS_G1K = WS_GN + (size_t)T_ * 32 * 4;
constexpr size_t WS_G1V = WS_G1K + (size_t)2048 * 256 * 2;
constexpr size_t WS_KC = WS_G1V + (size_t)2048 * 256 * 2;
constexpr size_t WS_VCT = WS_KC + (size_t)2048 * 128 * 2;
constexpr size_t WS_MIXEND = WS_VCT + (size_t)2048 * 128 * 2;
constexpr size_t WS_ACTEND = WS_ACT + al((size_t)T_ * FF_ * 2);
constexpr size_t WS_END = (WS_MIXEND > WS_ACTEND ? WS_MIXEND : WS_ACTEND) + 4096;
static_assert(WS_END <= (size_t)536870912, "workspace too large");

constexpr int LDS_BYTES = 132096;

struct Params {
    const float* x; const float* f1_pre_g; const float* f1_w_in; const float* f1_w_out; const float* f1_post_g;
    const float* mix_pre_g; const float* w_in; const float* cmp_pos_k; const float* cmp_k_w1; const float* cmp_k_w2;
    const float* cmp_pos_v; const float* cmp_v_w1; const float* cmp_v_w2; const float* w_branch_sb; const float* w_branch_nsa;
    const float* w_out; const float* mix_post_g; const float* f2_pre_g; const float* f2_w_in; const float* f2_w_out; const float* f2_post_g;
    float* out; unsigned char* ws; int ph_lo, ph_hi;
};

DI unsigned pk2(float a, float b) {
    unsigned ua = __float_as_uint(a), ub = __float_as_uint(b);
    ua += 0x7fffu + ((ua >> 16) & 1u); ub += 0x7fffu + ((ub >> 16) & 1u);
    return (ua >> 16) | (ub & 0xffff0000u);
}
DI bf16_t f2bf(float a) { unsigned ua = __float_as_uint(a); ua += 0x7fffu + ((ua >> 16) & 1u); return (bf16_t)(ua >> 16); }
DI float bf2f(bf16_t v) { return __uint_as_float(((unsigned)v) << 16); }
DI float wave_sum(float v) {
#pragma unroll
    for (int o = 32; o >= 1; o >>= 1) v += __shfl_xor(v, o);
    return v;
}
DI float sigmoidf_(float x) { return __builtin_amdgcn_rcpf(1.0f + __expf(-x)); }

template <int MAP> DI int map_col(int nv, int Nact) {
    if (MAP == 0) return nv < Nact ? nv : -1;
    if (MAP == 1) { const int p = nv >> 8, hh = (nv >> 7) & 1, i = nv & 127; return hh * FF_ + 128 * p + i; }
    if (nv < 2048) return nv;
    if (nv < 3584) return nv + 1024;
    if (nv < 3840) return 4608 + (nv - 3584);
    if (nv < 4096) return 5120 + (nv - 3840);
    if (nv < 8192) return 5656 + (nv - 4096);
    if (nv < 8216) return 5632 + (nv - 8192);
    if (nv < 8448) return -1;
    if (nv < 9472) return 2048 + (nv - 8448);
    if (nv < 9728) return 4864 + (nv - 9472);
    return 5376 + (nv - 9728);
}
template <int MAP> DI void convert_w(const float* __restrict__ W, int Kact, int Nact, bf16_t* __restrict__ Bt, int Kv, int Nv, unsigned* lds32, int bid, int G) {
    const int tid = threadIdx.x;
    const int tk = Kv >> 6, tn = Nv >> 6, ntile = tk * tn;
    for (int tile = bid; tile < ntile; tile += G) {
        const int n0 = (tile / tk) << 6, k0 = (tile % tk) << 6;
        const int nl = tid & 63, col = map_col<MAP>(n0 + nl, Nact);
#pragma unroll
        for (int i = 0; i < 4; ++i) {
            const int kp = (tid >> 6) + 8 * i;
            const int k = k0 + 2 * kp;
            float a = 0.f, b = 0.f;
            if (col >= 0) { if (k < Kact) a = W[(size_t)k * Nact + col]; if (k + 1 < Kact) b = W[(size_t)(k + 1) * Nact + col]; }
            lds32[nl * 33 + kp] = pk2(a, b);
        }
        __syncthreads();
        {
            const int row = tid >> 3, ch = tid & 7;
            u32x4 v; v.x = lds32[row * 33 + ch * 4 + 0]; v.y = lds32[row * 33 + ch * 4 + 1]; v.z = lds32[row * 33 + ch * 4 + 2]; v.w = lds32[row * 33 + ch * 4 + 3];
            *(u32x4*)(Bt + (size_t)(n0 + row) * Kv + k0 + ch * 8) = v;
        }
        __syncthreads();
    }
}
DI void cmp_bias(const float* __restrict__ pos, const float* __restrict__ w1, float* __restrict__ bias, float* ldsf) {
    const int tid = threadIdx.x, n = tid & 127, part = tid >> 7;
    float s = 0.f;
    for (int k = part * 1024; k < (part + 1) * 1024; ++k) s += pos[k] * w1[(size_t)k * 128 + n];
    ldsf[tid] = s;
    __syncthreads();
    if (tid < 128) bias[tid] = (ldsf[tid] + ldsf[tid + 128]) + (ldsf[tid + 256] + ldsf[tid + 384]);
    __syncthreads();
}

template <int MODE> DI void rowwise(const float* __restrict__ y, const float* base, float* xo, bf16_t* __restrict__ hout,
                                    const float* __restrict__ gp, const float* __restrict__ g1, float fac, int bid, int G) {
    const int lane = threadIdx.x & 63, wave = threadIdx.x >> 6;
    for (int row = bid * 8 + wave; row < T_; row += G * 8) {
        f32x4 v[8];
        if (MODE == 0) {
#pragma unroll
            for (int i = 0; i < 8; ++i) v[i] = *(const f32x4*)(y + (size_t)row * D_ + i * 256 + lane * 4);
        } else {
            float ss = 0.f;
#pragma unroll
            for (int i = 0; i < 8; ++i) { v[i] = *(const f32x4*)(y + (size_t)row * D_ + i * 256 + lane * 4); ss += (v[i][0] * v[i][0] + v[i][1] * v[i][1]) + (v[i][2] * v[i][2] + v[i][3] * v[i][3]); }
            ss = wave_sum(ss);
            const float r = rsqrtf(ss * (1.0f / D_) + EPS) * fac;
#pragma unroll
            for (int i = 0; i < 8; ++i) {
                const f32x4 bs = *(const f32x4*)(base + (size_t)row * D_ + i * 256 + lane * 4);
                const f32x4 gg = *(const f32x4*)(gp + i * 256 + lane * 4);
                v[i] = bs + v[i] * r * gg;
                *(f32x4*)(xo + (size_t)row * D_ + i * 256 + lane * 4) = v[i];
            }
        }
        if (MODE != 2) {
            float ss = 0.f;
#pragma unroll
            for (int i = 0; i < 8; ++i) ss += (v[i][0] * v[i][0] + v[i][1] * v[i][1]) + (v[i][2] * v[i][2] + v[i][3] * v[i][3]);
            ss = wave_sum(ss);
            const float r = rsqrtf(ss * (1.0f / D_) + EPS);
#pragma unroll
            for (int i = 0; i < 8; ++i) {
                const f32x4 gg = *(const f32x4*)(g1 + i * 256 + lane * 4);
                const f32x4 o = v[i] * r * gg;
                u32x2 w; w.x = pk2(o[0], o[1]); w.y = pk2(o[2], o[3]);
                *(u32x2*)(hout + (size_t)row * D_ + i * 256 + lane * 4) = w;
            }
        }
    }
}

using pg8::Unit; using pg8::HALF; using pg8::BM;
struct EpiSwiglu {
    static constexpr bool PERM = true, AFTER_DRAIN = false;
    bf16_t* O;
    DI void operator()(const f32x4 (&acc)[2][2][4][2], const Unit& u, int wr, int wc, int fr, int fq) const {
        const int row0 = u.pm * BM + wr * 64 + fr, col0 = u.pn * 128 + wc * 32 + 8 * fq;
#pragma unroll
        for (int ai = 0; ai < 2; ++ai)
#pragma unroll
            for (int m = 0; m < 4; ++m) {
                float o[8];
#pragma unroll
                for (int n = 0; n < 2; ++n)
#pragma unroll
                    for (int j = 0; j < 4; ++j) { const float gt = acc[ai][0][m][n][j], up = acc[ai][1][m][n][j]; o[n * 4 + j] = gt * __builtin_amdgcn_rcpf(1.0f + __expf(-gt)) * up; }
                u32x4 w; w.x = pk2(o[0], o[1]); w.y = pk2(o[2], o[3]); w.z = pk2(o[4], o[5]); w.w = pk2(o[6], o[7]);
                *(u32x4*)(O + (size_t)(row0 + ai * HALF + m * 16) * FF_ + col0) = w;
            }
    }
};
struct EpiInprojA {
    static constexpr bool PERM = true, AFTER_DRAIN = false;
    unsigned char* ws;
    DI void operator()(const f32x4 (&acc)[2][2][4][2], const Unit& u, int wr, int wc, int fr, int fq) const {
        const int pn = __builtin_amdgcn_readfirstlane(u.pn);
        const int row0 = __builtin_amdgcn_readfirstlane(u.pm) * BM + wr * 64 + fr;
        const int cl0 = wc * 32 + 8 * fq;
        if (pn == 32) {
            float* gn = (float*)(ws + WS_GN);
            if (wc == 0) {
#pragma unroll
                for (int ai = 0; ai < 2; ++ai)
#pragma unroll
                    for (int m = 0; m < 4; ++m) {
                        const int r = row0 + ai * HALF + m * 16;
#pragma unroll
                        for (int n = 0; n < 2; ++n) { f32x4 v = acc[ai][0][m][n]; f32x4 o; for (int j = 0; j < 4; ++j) o[j] = sigmoidf_(v[j]); *(f32x4*)(gn + (size_t)r * 32 + cl0 + 4 * n) = o; }
                    }
            }
            return;
        }
        bf16_t* base; int pitch, cbase; bool sig = false, dense = false;
        if (pn < 4) { base = (bf16_t*)(ws + WS_QSB); pitch = 1024; cbase = pn * 256; }
        else if (pn < 8) { base = (bf16_t*)(ws + WS_KSB); pitch = 1024; cbase = (pn - 4) * 256; }
        else if (pn < 12) { base = (bf16_t*)(ws + WS_QNSA); pitch = 1024; cbase = (pn - 8) * 256; }
        else if (pn == 12) { base = (bf16_t*)(ws + WS_KCK); pitch = 128; cbase = 0; dense = true; }
        else if (pn == 13) { base = (bf16_t*)(ws + WS_KCV); pitch = 128; cbase = 0; dense = true; }
        else if (pn == 14) { base = (bf16_t*)(ws + WS_KSLC); pitch = 256; cbase = 0; }
        else if (pn == 15) { base = (bf16_t*)(ws + WS_KWIN); pitch = 256; cbase = 0; }
        else { base = (bf16_t*)(ws + WS_Y); pitch = 4096; cbase = (pn - 16) * 256; sig = true; }
#pragma unroll
        for (int ai = 0; ai < 2; ++ai)
#pragma unroll
            for (int m = 0; m < 4; ++m) {
                const int r = row0 + ai * HALF + m * 16;
#pragma unroll
                for (int bj = 0; bj < 2; ++bj) {
                    f32x4 v0 = acc[ai][bj][m][0], v1 = acc[ai][bj][m][1];
                    if (sig) { for (int j = 0; j < 4; ++j) { v0[j] = sigmoidf_(v0[j]); v1[j] = sigmoidf_(v1[j]); } }
                    u32x4 w; w.x = pk2(v0[0], v0[1]); w.y = pk2(v0[2], v0[3]); w.z = pk2(v1[0], v1[1]); w.w = pk2(v1[2], v1[3]);
                    const int c = bj * HALF + cl0;
                    size_t off;
                    if (dense) { const int b = r >> 12, s = r & 4095, g = c >> 7, d = c & 127; off = ((size_t)((b * 2 + g) * S_ + s)) * 128 + d; }
                    else off = (size_t)r * pitch + cbase + c;
                    *(u32x4*)(base + off) = w;
                }
            }
    }
};
struct EpiInprojB {
    static constexpr bool PERM = true, AFTER_DRAIN = false;
    unsigned char* ws;
    DI void operator()(const f32x4 (&acc)[2][2][4][2], const Unit& u, int wr, int wc, int fr, int fq) const {
        const int pn = __builtin_amdgcn_readfirstlane(u.pn);
        const int row0 = __builtin_amdgcn_readfirstlane(u.pm) * BM + wr * 64 + fr;
        const int cl0 = wc * 32 + 8 * fq;
        bf16_t* vt; int ncol, cbase;
        if (pn < 4) { vt = (bf16_t*)(ws + WS_VTSB); ncol = 1024; cbase = pn * 256; }
        else if (pn == 4) { vt = (bf16_t*)(ws + WS_VTSLC); ncol = 256; cbase = 0; }
        else { vt = (bf16_t*)(ws + WS_VTWIN); ncol = 256; cbase = 0; }
#pragma unroll
        for (int ai = 0; ai < 2; ++ai)
#pragma unroll
            for (int m = 0; m < 4; ++m) {
                const int r = row0 + ai * HALF + m * 16, b = r >> 12, s = r & 4095;
                bf16_t* pp = vt + ((size_t)(b * ncol + cbase + cl0)) * S_ + s;
#pragma unroll
                for (int bj = 0; bj < 2; ++bj) {
#pragma unroll
                    for (int n = 0; n < 2; ++n)
#pragma unroll
                        for (int j = 0; j < 4; ++j) { *pp = f2bf(acc[ai][bj][m][n][j]); pp += S_; asm volatile("" : "+v"(pp)); }
                    pp += (size_t)(HALF - 8) * S_; asm volatile("" : "+v"(pp));
                }
            }
    }
};
DI float gelu_tanh(float x) { const float u = 0.7978845608028654f * (x + 0.044715f * x * x * x); const float e = __expf(2.0f * u); const float th = 1.0f - 2.0f / (e + 1.0f); return 0.5f * x * (1.0f + th); }
struct EpiCmp1 {
    static constexpr bool PERM = true, AFTER_DRAIN = false;
    bf16_t* O; const float* bias;
    DI void operator()(const f32x4 (&acc)[2][2][4][2], const Unit& u, int wr, int wc, int fr, int fq) const {
        const int row0 = u.pm * BM + wr * 64 + fr, cl0 = wc * 32 + 8 * fq;
        const f32x4 b0 = *(const f32x4*)(bias + cl0), b1 = *(const f32x4*)(bias + cl0 + 4);
#pragma unroll
        for (int ai = 0; ai < 2; ++ai)
#pragma unroll
            for (int m = 0; m < 4; ++m) {
                const int r = row0 + ai * HALF + m * 16;
                f32x4 v0 = acc[ai][0][m][0] + b0, v1 = acc[ai][0][m][1] + b1;
                for (int j = 0; j < 4; ++j) { v0[j] = gelu_tanh(v0[j]); v1[j] = gelu_tanh(v1[j]); }
                u32x4 w; w.x = pk2(v0[0], v0[1]); w.y = pk2(v0[2], v0[3]); w.z = pk2(v1[0], v1[1]); w.w = pk2(v1[2], v1[3]);
                *(u32x4*)(O + (size_t)r * 256 + cl0) = w;
                u32x4 z; z.x = 0; z.y = 0; z.z = 0; z.w = 0;
                *(u32x4*)(O + (size_t)r * 256 + 128 + cl0) = z;
            }
    }
};
template <int TRANSP> struct EpiCmp2 {
    static constexpr bool PERM = true, AFTER_DRAIN = false;
    bf16_t* O;
    DI void operator()(const f32x4 (&acc)[2][2][4][2], const Unit& u, int wr, int wc, int fr, int fq) const {
        const int row0 = u.pm * BM + wr * 64 + fr, cl0 = wc * 32 + 8 * fq;
#pragma unroll
        for (int ai = 0; ai < 2; ++ai)
#pragma unroll
            for (int m = 0; m < 4; ++m) {
                const int r = row0 + ai * HALF + m * 16;
                const f32x4 v0 = acc[ai][0][m][0], v1 = acc[ai][0][m][1];
                if (TRANSP == 0) {
                    u32x4 w; w.x = pk2(v0[0], v0[1]); w.y = pk2(v0[2], v0[3]); w.z = pk2(v1[0], v1[1]); w.w = pk2(v1[2], v1[3]);
                    *(u32x4*)(O + (size_t)r * 128 + cl0) = w;
                } else {
#pragma unroll
                    for (int j = 0; j < 4; ++j) { O[((size_t)(u.pm * 128 + cl0 + j)) * 256 + (r & 255)] = f2bf(v0[j]); O[((size_t)(u.pm * 128 + cl0 + 4 + j)) * 256 + (r & 255)] = f2bf(v1[j]); }
                }
            }
    }
};
template <int SECOND> struct EpiBranch {
    static constexpr bool PERM = true, AFTER_DRAIN = false;
    bf16_t* Hh; const bf16_t* Gm;
    DI void operator()(const f32x4 (&acc)[2][2][4][2], const Unit& u, int wr, int wc, int fr, int fq) const {
        const int row0 = u.pm * BM + wr * 64 + fr, col0 = u.pn * BM + wc * 32 + 8 * fq;
#pragma unroll
        for (int ai = 0; ai < 2; ++ai)
#pragma unroll
            for (int m = 0; m < 4; ++m) {
                const int r = row0 + ai * HALF + m * 16;
#pragma unroll
                for (int bj = 0; bj < 2; ++bj) {
                    const int c = col0 + bj * HALF;
                    const u32x4 gw = *(const u32x4*)(Gm + (size_t)r * 4096 + SECOND * 2048 + c);
                    float o[8];
#pragma unroll
                    for (int n = 0; n < 2; ++n)
#pragma unroll
                        for (int j = 0; j < 4; ++j) o[n * 4 + j] = acc[ai][bj][m][n][j];
                    const unsigned gws[4] = {gw.x, gw.y, gw.z, gw.w};
#pragma unroll
                    for (int q = 0; q < 4; ++q) { o[2 * q] *= __uint_as_float(gws[q] << 16); o[2 * q + 1] *= __uint_as_float(gws[q] & 0xffff0000u); }
                    if (SECOND) {
                        const u32x4 hw = *(const u32x4*)(Hh + (size_t)r * D_ + c);
                        const unsigned hws[4] = {hw.x, hw.y, hw.z, hw.w};
#pragma unroll
                        for (int q = 0; q < 4; ++q) { o[2 * q] += __uint_as_float(hws[q] << 16); o[2 * q + 1] += __uint_as_float(hws[q] & 0xffff0000u); }
                    }
                    u32x4 w; w.x = pk2(o[0], o[1]); w.y = pk2(o[2], o[3]); w.z = pk2(o[4], o[5]); w.w = pk2(o[6], o[7]);
                    *(u32x4*)(Hh + (size_t)r * D_ + c) = w;
                }
            }
    }
};

constexpr int KPITCH = 272, VPITCH = 136, KBYTES = 64 * KPITCH, VBYTES = 128 * VPITCH, TILE_BYTES = KBYTES + VBYTES;
#define MFMA32(a, b, c) __builtin_amdgcn_mfma_f32_32x32x16_bf16((a), (b), (c), 0, 0, 0)
struct KVRegs { u32x4 k[2]; u32x4 v[2]; };
DI void kv_load(KVRegs& R, const bf16_t* Kp, unsigned kpitch, const bf16_t* Vp, unsigned vpitch, int tid) {
#pragma unroll
    for (int i = 0; i < 2; ++i) { const unsigned c = tid + 512 * i; const unsigned off = (c >> 4) * kpitch + (c & 15) * 8; R.k[i] = *(const u32x4*)(Kp + off); }
#pragma unroll
    for (int i = 0; i < 2; ++i) { const unsigned c = tid + 512 * i; const unsigned off = (c >> 3) * vpitch + (c & 7) * 8; R.v[i] = *(const u32x4*)(Vp + off); }
}
DI void kv_store(const KVRegs& R, unsigned char* buf, int tid) {
#pragma unroll
    for (int i = 0; i < 2; ++i) { const int c = tid + 512 * i; *(u32x4*)(buf + (c >> 4) * KPITCH + (c & 15) * 16) = R.k[i]; }
#pragma unroll
    for (int i = 0; i < 2; ++i) { const int c = tid + 512 * i; unsigned char* p = buf + KBYTES + (c >> 3) * VPITCH + (c & 7) * 16;
        u32x2 a; a.x = R.v[i].x; a.y = R.v[i].y; u32x2 b; b.x = R.v[i].z; b.y = R.v[i].w; *(u32x2*)p = a; *(u32x2*)(p + 8) = b; }
}
DI void qk_tile(const unsigned char* kt, const bf16x8 (&qf)[8], f32x16 (&s)[2], int lane) {
    const int key = lane & 31, h = lane >> 5;
    const unsigned char* base = kt + key * KPITCH + h * 16;
#pragma unroll
    for (int kb = 0; kb < 2; ++kb) {
#pragma unroll
        for (int i = 0; i < 16; ++i) s[kb][i] = 0.f;
#pragma unroll
        for (int kg = 0; kg < 2; ++kg) {
            bf16x8 a[4];
#pragma unroll
            for (int q = 0; q < 4; ++q) a[q] = *(const bf16x8*)(base + kb * 32 * KPITCH + (kg * 4 + q) * 32);
#pragma unroll
            for (int q = 0; q < 4; ++q) s[kb] = MFMA32(a[q], qf[kg * 4 + q], s[kb]);
            __builtin_amdgcn_sched_barrier(0);
        }
    }
}
DI void pv_tile(const unsigned char* vt, const bf16x8 (&pf)[4], f32x16 (&o)[4], int lane) {
    const int dl = lane & 31, h = lane >> 5;
    const unsigned char* base = vt + dl * VPITCH + 8 * h;
#pragma unroll
    for (int db = 0; db < 4; ++db) {
        bf16x8 a[4];
#pragma unroll
        for (int kk = 0; kk < 4; ++kk) {
            const unsigned char* p = base + db * 32 * VPITCH + kk * 32;
            const s16x4 lo = *(const s16x4*)p, hi = *(const s16x4*)(p + 16);
            a[kk] = __builtin_shufflevector(lo, hi, 0, 1, 2, 3, 4, 5, 6, 7);
        }
#pragma unroll
        for (int kk = 0; kk < 4; ++kk) o[db] = MFMA32(a[kk], pf[kk], o[db]);
        __builtin_amdgcn_sched_barrier(0);
    }
}
DI void qk_half(const unsigned char* kt, int kb, const bf16x8 (&qf)[8], f32x16& s1, int lane) {
    const int key = lane & 31, h = lane >> 5;
    const unsigned char* base = kt + (kb * 32 + key) * KPITCH + h * 16;
#pragma unroll
    for (int i = 0; i < 16; ++i) s1[i] = 0.f;
#pragma unroll
    for (int kg = 0; kg < 2; ++kg) {
        bf16x8 a[4];
#pragma unroll
        for (int q = 0; q < 4; ++q) a[q] = *(const bf16x8*)(base + (kg * 4 + q) * 32);
#pragma unroll
        for (int q = 0; q < 4; ++q) s1 = MFMA32(a[q], qf[kg * 4 + q], s1);
        __builtin_amdgcn_sched_barrier(0);
    }
}
DI void pv_half(const unsigned char* vt, int kb, const bf16x8 (&pf)[2], f32x16 (&o)[4], int lane) {
    const int dl = lane & 31, h = lane >> 5;
    const unsigned char* base = vt + dl * VPITCH + 8 * h + kb * 64;
#pragma unroll
    for (int dp = 0; dp < 2; ++dp) {
        bf16x8 a[4];
#pragma unroll
        for (int q = 0; q < 4; ++q) {
            const unsigned char* p = base + (dp * 2 + (q >> 1)) * 32 * VPITCH + (q & 1) * 32;
            const s16x4 lo = *(const s16x4*)p, hi = *(const s16x4*)(p + 16);
            a[q] = __builtin_shufflevector(lo, hi, 0, 1, 2, 3, 4, 5, 6, 7);
        }
#pragma unroll
        for (int q = 0; q < 4; ++q) o[dp * 2 + (q >> 1)] = MFMA32(a[q], pf[q & 1], o[dp * 2 + (q >> 1)]);
        __builtin_amdgcn_sched_barrier(0);
    }
}
DI void pack_half(const f32x16& s1, bf16x8 (&pf)[2]) {
#pragma unroll
    for (int ss = 0; ss < 2; ++ss) {
        u32x4 w; w.x = pk2(s1[8 * ss + 0], s1[8 * ss + 1]); w.y = pk2(s1[8 * ss + 2], s1[8 * ss + 3]); w.z = pk2(s1[8 * ss + 4], s1[8 * ss + 5]); w.w = pk2(s1[8 * ss + 6], s1[8 * ss + 7]);
        pf[ss] = __builtin_bit_cast(bf16x8, w);
    }
}
DI void pack_p(const f32x16 (&s)[2], bf16x8 (&pf)[4]) {
#pragma unroll
    for (int kb = 0; kb < 2; ++kb)
#pragma unroll
        for (int ss = 0; ss < 2; ++ss) {
            u32x4 w; w.x = pk2(s[kb][8 * ss + 0], s[kb][8 * ss + 1]); w.y = pk2(s[kb][8 * ss + 2], s[kb][8 * ss + 3]); w.z = pk2(s[kb][8 * ss + 4], s[kb][8 * ss + 5]); w.w = pk2(s[kb][8 * ss + 6], s[kb][8 * ss + 7]);
            pf[kb * 2 + ss] = __builtin_bit_cast(bf16x8, w);
        }
}
DI void store_o(bf16_t* orow, const f32x16 (&o)[4], int lane) {
    const int h = lane >> 5;
#pragma unroll
    for (int db = 0; db < 4; ++db)
#pragma unroll
        for (int g4 = 0; g4 < 4; ++g4) {
            u32x2 w; w.x = pk2(o[db][4 * g4 + 0], o[db][4 * g4 + 1]); w.y = pk2(o[db][4 * g4 + 2], o[db][4 * g4 + 3]);
            *(u32x2*)(orow + db * 32 + g4 * 8 + 4 * h) = w;
        }
}

DI void sb_item(unsigned char* ws, unsigned char* lds, int b, int hh, int qblk) {
    const int tid = threadIdx.x, lane = tid & 63, wave = __builtin_amdgcn_readfirstlane(tid >> 6), col = lane & 31, h = lane >> 5;
    const int t = qblk * 256 + wave * 32 + col;
    bf16_t* qrow = (bf16_t*)(ws + WS_QSB) + ((size_t)(b * S_ + t)) * 1024 + hh * 128;
    bf16x8 qf[8];
#pragma unroll
    for (int ks = 0; ks < 8; ++ks) qf[ks] = *(const bf16x8*)(qrow + ks * 16 + h * 8);
    f32x16 o[4];
#pragma unroll
    for (int db = 0; db < 4; ++db)
#pragma unroll
        for (int i = 0; i < 16; ++i) o[db][i] = 0.f;
    float R = 0.f;
    const bf16_t* Kb = (const bf16_t*)(ws + WS_KSB) + ((size_t)b * S_) * 1024 + hh * 128;
    const bf16_t* Vb = (const bf16_t*)(ws + WS_VTSB) + ((size_t)(b * 8 + hh) * 128) * S_;
    const int nt = qblk * 4 + 4;
    const int wmax = (qblk * 256 + wave * 32 + 30) >> 6;
    KVRegs Rg;
    kv_load(Rg, Kb + (size_t)((nt - 1) * 64) * 1024, 1024, Vb + (nt - 1) * 64, S_, tid);
    kv_store(Rg, lds, tid);
    __syncthreads();
    for (int it = 0; it < nt; ++it) {
        const int kt = nt - 1 - it, cur = it & 1;
        if (it + 1 < nt) kv_load(Rg, Kb + (size_t)((kt - 1) * 64) * 1024, 1024, Vb + (kt - 1) * 64, S_, tid);
        if (kt <= wmax) {
            const unsigned char* buf = lds + cur * TILE_BYTES;
            f32x16 s[2], lm[2];
            qk_tile(buf, qf, s, lane);
            const int key0 = kt * 64;
#pragma unroll
            for (int kb = 0; kb < 2; ++kb)
#pragma unroll
                for (int i = 0; i < 16; ++i) {
                    const int kpos = key0 + 32 * kb + 8 * (i >> 2) + 4 * h + (i & 3);
                    const float z = s[kb][i] * QSCALE;
                    const float sp = __logf(1.0f + __expf(-fabsf(z)));
                    const bool valid = kpos < t;
                    s[kb][i] = valid ? z : 0.f;
                    lm[kb][i] = valid ? -(fmaxf(z, 0.f) + sp) : 0.f;
                }
            float own[8], par[8], sufg[8];
#pragma unroll
            for (int m = 0; m < 8; ++m) { const int kb = m >> 2, g4 = m & 3; own[m] = (lm[kb][4 * g4] + lm[kb][4 * g4 + 1]) + (lm[kb][4 * g4 + 2] + lm[kb][4 * g4 + 3]); }
#pragma unroll
            for (int m = 0; m < 8; ++m) par[m] = __shfl_xor(own[m], 32);
            float Tt = 0.f;
#pragma unroll
            for (int m = 7; m >= 0; --m) { sufg[m] = Tt + (h == 0 ? par[m] : 0.f); Tt += own[m] + par[m]; }
#pragma unroll
            for (int kb = 0; kb < 2; ++kb)
#pragma unroll
                for (int g4 = 0; g4 < 4; ++g4) {
                    float run = R + sufg[kb * 4 + g4];
#pragma unroll
                    for (int i = 3; i >= 0; --i) {
                        const int idx = 4 * g4 + i;
                        const int kpos = key0 + 32 * kb + 8 * g4 + 4 * h + i;
                        const float l1 = lm[kb][idx];
                        const float lb = l1 + s[kb][idx];
                        const float w = (kpos < t) ? __expf(lb + run) : 0.f;
                        run += l1;
                        s[kb][idx] = w;
                    }
                }
            R += Tt;
            bf16x8 pf[4];
            pack_p(s, pf);
            pv_tile(buf + KBYTES, pf, o, lane);
        }
        if (it + 1 < nt) kv_store(Rg, lds + (cur ^ 1) * TILE_BYTES, tid);
        __syncthreads();
    }
    store_o(qrow, o, lane);
}

constexpr int SC_PITCH = 65;
constexpr int NSA_SCA = 2 * TILE_BYTES, NSA_SCB = NSA_SCA + 64 * SC_PITCH * 4, NSA_UNI = NSA_SCB + 64 * SC_PITCH * 4, NSA_SEL = NSA_UNI + 16, NSA_STASH = NSA_SEL + 64 * 8, NSA_END = NSA_STASH + 512 * 8;
static_assert(NSA_END <= LDS_BYTES, "LDS");
template <int MK, int OP> DI void nsa_branch(unsigned long long tiles, const bf16_t* Kp, unsigned kpitch, const bf16_t* Vp, unsigned vpitch, unsigned char* lds,
                                       const bf16x8 (&qf)[8], int t, float slope2, float& m, float& l, f32x16 (&o)[4], float pscale, unsigned mlo, unsigned mhi, int qloc, int r) {
    const int tid = threadIdx.x, lane = tid & 63, h = lane >> 5;
    const float sc2 = QSCALE * LOG2E;
    unsigned tlo = __builtin_amdgcn_readfirstlane((unsigned)tiles), thi = __builtin_amdgcn_readfirstlane((unsigned)(tiles >> 32));
    unsigned long long tl = ((unsigned long long)thi << 32) | tlo;
    if (tl == 0ull) return;
    int j = __builtin_ctzll(tl); tl &= tl - 1;
    int cur = 0;
    KVRegs Rg;
    kv_load(Rg, Kp + (size_t)(j * 64) * kpitch, kpitch, Vp + j * 64, vpitch, tid);
    kv_store(Rg, lds, tid);
    __syncthreads();
    for (;;) {
        int jn = -1;
        if (tl != 0ull) { jn = __builtin_ctzll(tl); tl &= tl - 1; kv_load(Rg, Kp + (size_t)(jn * 64) * kpitch, kpitch, Vp + jn * 64, vpitch, tid); }
        const unsigned char* buf = lds + cur * TILE_BYTES;
        const int key0 = j * 64;
        const bool selbit = (MK == 1) ? (((j < 32 ? (mlo >> j) : (mhi >> (j - 32))) & 1u) != 0u) : true;
        int dbase = (MK == 0) ? (t - 31 - 16 * (key0 + 4 * h)) : (t - key0 - 4 * h);
        asm volatile("" : "+v"(dbase));
        const float fbase = (float)dbase;
#pragma unroll
        for (int kb = 0; kb < 2; ++kb) {
            f32x16 s1;
            __builtin_amdgcn_sched_barrier(0);
            qk_half(buf, kb, qf, s1, lane);
            float tm = -1e30f;
#pragma unroll
            for (int i = 0; i < 16; ++i) {
                const int e = 32 * kb + 8 * (i >> 2) + (i & 3);
                const int dstep = (MK == 0) ? 16 : 1;
                const int dist = dbase - dstep * e;
                const float fdist = fbase - (float)(dstep * e);
                bool valid;
                if (MK == 0) valid = dist >= 0;
                else if (MK == 1) valid = (dist >= 0) && selbit;
                else valid = (dist >= 0) && (dist < 512);
                const float v = valid ? (s1[i] * sc2 - slope2 * fdist) : -1e30f;
                s1[i] = v;
                tm = fmaxf(tm, v);
            }
            if (OP == 1) {
                float A[4], Bv[4];
#pragma unroll
                for (int i = 0; i < 16; ++i) { const float v = s1[i]; s1[i] = (v > -1e29f) ? __builtin_amdgcn_exp2f(v - m) * l : 0.f; }
#pragma unroll
                for (int g4 = 0; g4 < 4; ++g4) { A[g4] = s1[4 * g4] + 2.0f * ((s1[4 * g4 + 1] + s1[4 * g4 + 2]) + s1[4 * g4 + 3]); Bv[g4] = s1[4 * g4]; }
#pragma unroll
                for (int g4 = 0; g4 < 4; ++g4) { A[g4] += __shfl_xor(A[g4], 8); A[g4] += __shfl_xor(A[g4], 16); Bv[g4] += __shfl_xor(Bv[g4], 8); Bv[g4] += __shfl_xor(Bv[g4], 16); }
                float* scA = (float*)(lds + NSA_SCA); float* scB = (float*)(lds + NSA_SCB);
#pragma unroll
                for (int g4 = 0; g4 < 4; ++g4) {
                    const int jj = j * 16 + kb * 8 + 2 * g4 + h;
                    if (r == 0) scA[qloc * SC_PITCH + jj] = A[g4];
                    if (r == 1 && jj >= 1) scB[qloc * SC_PITCH + jj - 1] = Bv[g4];
                }
            } else if (OP == 3) {
#pragma unroll
                for (int i = 0; i < 16; ++i) { const float v = s1[i]; s1[i] = (v > -1e29f) ? __builtin_amdgcn_exp2f(v - m) * pscale : 0.f; }
                bf16x8 pf[2];
                pack_half(s1, pf);
                __builtin_amdgcn_sched_barrier(0);
                pv_half(buf + KBYTES, kb, pf, o, lane);
            } else {
                tm = fmaxf(tm, __shfl_xor(tm, 32));
                const float mn = fmaxf(m, tm);
                const float alpha = __builtin_amdgcn_exp2f(m - mn);
                float ps = 0.f;
#pragma unroll
                for (int i = 0; i < 16; ++i) { const float v = s1[i]; const float p = (v > -1e29f) ? __builtin_amdgcn_exp2f(v - mn) : 0.f; s1[i] = p; ps += p; }
                l = l * alpha + ps;
                m = mn;
                if (OP == 2) {
#pragma unroll
                    for (int db = 0; db < 4; ++db)
#pragma unroll
                        for (int i = 0; i < 16; ++i) o[db][i] *= alpha;
                    bf16x8 pf[2];
                    pack_half(s1, pf);
                    __builtin_amdgcn_sched_barrier(0);
                    pv_half(buf + KBYTES, kb, pf, o, lane);
                }
            }
        }
        if (jn >= 0) kv_store(Rg, lds + (cur ^ 1) * TILE_BYTES, tid);
        __syncthreads();
        if (jn < 0) break;
        j = jn; cur ^= 1;
    }
}

DI void nsa_item(unsigned char* ws, unsigned char* lds, int b, int g, int qb) {
    const int tid = threadIdx.x, lane = tid & 63, wave = __builtin_amdgcn_readfirstlane(tid >> 6), col = lane & 31, h = lane >> 5;
    const int r = col >> 3, qi = col & 7, qloc = wave * 8 + qi;
    const int t = qb * 64 + qloc, head = g * 4 + r;
    const float slope2 = exp2f(-(float)(head + 1)) * LOG2E;
    const bf16_t* qrow = (const bf16_t*)(ws + WS_QNSA) + ((size_t)(b * S_ + t)) * 1024 + head * 128;
    bf16x8 qf[8];
#pragma unroll
    for (int ks = 0; ks < 8; ++ks) qf[ks] = *(const bf16x8*)(qrow + ks * 16 + h * 8);
    float* stash = (float*)(lds + NSA_STASH) + tid * 2;
    float* scA = (float*)(lds + NSA_SCA); float* scB = (float*)(lds + NSA_SCB);
    unsigned* selm = (unsigned*)(lds + NSA_SEL); unsigned* uni = (unsigned*)(lds + NSA_UNI);
    for (int i = tid; i < 2 * 64 * SC_PITCH + 4; i += NTHREADS) scA[i] = 0.f;
    __syncthreads();
    f32x16 o[4];
#pragma unroll
    for (int db = 0; db < 4; ++db)
#pragma unroll
        for (int i = 0; i < 16; ++i) o[db][i] = 0.f;
    const bf16_t* Kc = (const bf16_t*)(ws + WS_KC) + ((size_t)(b * 2 + g) * 256) * 128;
    const bf16_t* Vc = (const bf16_t*)(ws + WS_VCT) + ((size_t)(b * 2 + g) * 128) * 256;
    const int ntc = ((4 * qb + 2) >> 6) + 1;
    const unsigned long long ctiles = (1ull << ntc) - 1ull;
    {
        float m_c = -1e30f, inv_c = 0.f;
        float l = 0.f;
        nsa_branch<0, 0>(ctiles, Kc, 128, Vc, 256, lds, qf, t, slope2, m_c, l, o, 0.f, 0u, 0u, qloc, r);
        l += __shfl_xor(l, 32);
        inv_c = (l > 0.f) ? 1.0f / l : 0.f;
        nsa_branch<0, 1>(ctiles, Kc, 128, Vc, 256, lds, qf, t, slope2, m_c, inv_c, o, 0.f, 0u, 0u, qloc, r);
        stash[0] = m_c; stash[1] = inv_c;
    }
    {
        const int qq = tid >> 3, sub = tid & 7;
        float cand[8];
#pragma unroll
        for (int k = 0; k < 8; ++k) {
            const int jj = sub * 8 + k;
            float v = scA[qq * SC_PITCH + jj] + scB[qq * SC_PITCH + jj];
            if (jj == 0 || jj == qb || jj == qb - 1) v = 1e9f;
            if (jj > qb) v = -1e30f;
            cand[k] = v;
        }
        __syncthreads();
#pragma unroll
        for (int k = 0; k < 8; ++k) scA[qq * SC_PITCH + sub * 8 + k] = cand[k];
        __syncthreads();
        int cnt[8];
#pragma unroll
        for (int k = 0; k < 8; ++k) cnt[k] = 0;
        for (int jp = 0; jp < 64; ++jp) {
            const float v = scA[qq * SC_PITCH + jp];
#pragma unroll
            for (int k = 0; k < 8; ++k) { const int jj = sub * 8 + k; cnt[k] += ((v > cand[k]) || (v == cand[k] && jp < jj)) ? 1 : 0; }
        }
        unsigned bits = 0u;
#pragma unroll
        for (int k = 0; k < 8; ++k) if (cnt[k] < 16 && (sub * 8 + k) <= qb) bits |= (1u << k);
        unsigned lo = (sub < 4) ? (bits << (8 * sub)) : 0u, hi = (sub >= 4) ? (bits << (8 * (sub - 4))) : 0u;
        lo |= __shfl_xor(lo, 1); lo |= __shfl_xor(lo, 2); lo |= __shfl_xor(lo, 4);
        hi |= __shfl_xor(hi, 1); hi |= __shfl_xor(hi, 2); hi |= __shfl_xor(hi, 4);
        if (sub == 0) { selm[qq * 2] = lo; selm[qq * 2 + 1] = hi; atomicOr(&uni[0], lo); atomicOr(&uni[1], hi); }
        __syncthreads();
    }
    {
        const unsigned mlo = selm[qloc * 2], mhi = selm[qloc * 2 + 1];
        const unsigned long long un = ((unsigned long long)uni[1] << 32) | uni[0];
        const bf16_t* Ks = (const bf16_t*)(ws + WS_KSLC) + ((size_t)b * S_) * 256 + g * 128;
        const bf16_t* Vs = (const bf16_t*)(ws + WS_VTSLC) + ((size_t)(b * 2 + g) * 128) * S_;
        float m = -1e30f, l = 0.f;
        nsa_branch<1, 2>(un, Ks, 256, Vs, S_, lds, qf, t, slope2, m, l, o, 0.f, mlo, mhi, qloc, r);
        l += __shfl_xor(l, 32);
        const float g_s = ((const float*)(ws + WS_GN))[(b * S_ + t) * 32 + 8 + g * 4 + ((lane & 31) >> 3)]; const float f = (l > 0.f) ? g_s / l : 0.f;
#pragma unroll
        for (int db = 0; db < 4; ++db)
#pragma unroll
            for (int i = 0; i < 16; ++i) o[db][i] *= f;
    }
    {
        float mm = stash[0], ll = 0.f;
        const float g_c = ((const float*)(ws + WS_GN))[(b * S_ + t) * 32 + g * 4 + ((lane & 31) >> 3)];
        nsa_branch<0, 3>(ctiles, Kc, 128, Vc, 256, lds, qf, t, slope2, mm, ll, o, stash[1] * g_c, 0u, 0u, qloc, r);
    }
    {
        const int lo_t = qb >= 8 ? qb - 8 : 0;
        const unsigned long long tiles = ((qb == 63) ? ~0ull : ((1ull << (qb + 1)) - 1ull)) & ~((1ull << lo_t) - 1ull);
        const bf16_t* Kw = (const bf16_t*)(ws + WS_KWIN) + ((size_t)b * S_) * 256 + g * 128;
        const bf16_t* Vw = (const bf16_t*)(ws + WS_VTWIN) + ((size_t)(b * 2 + g) * 128) * S_;
        float m = -1e30f, l = 0.f;
        nsa_branch<2, 0>(tiles, Kw, 256, Vw, S_, lds, qf, t, slope2, m, l, o, 0.f, 0u, 0u, qloc, r);
        l += __shfl_xor(l, 32);
        const float g_w = ((const float*)(ws + WS_GN))[(b * S_ + t) * 32 + 16 + g * 4 + ((lane & 31) >> 3)]; const float f = (l > 0.f) ? g_w / l : 0.f;
        nsa_branch<2, 3>(tiles, Kw, 256, Vw, S_, lds, qf, t, slope2, m, l, o, f, 0u, 0u, qloc, r);
    }
    {
        int tid2 = threadIdx.x; asm volatile("" : "+v"(tid2));
        const int col2 = tid2 & 31, t2 = qb * 64 + (tid2 >> 6) * 8 + (col2 & 7), head2 = g * 4 + (col2 >> 3);
        store_o((bf16_t*)(ws + WS_QNSA) + ((size_t)(b * S_ + t2)) * 1024 + head2 * 128, o, tid2 & 63);
    }
}
}

using mk::Params;
__global__ void __launch_bounds__(512, 2) mega_fwd(Params p) {
    extern __shared__ __attribute__((aligned(16))) unsigned char lds[];
    cg::grid_group grid = cg::this_grid();
    using namespace mk;
    const int G = gridDim.x, bid = blockIdx.x;
    PG8_LAS unsigned char* l3 = (PG8_LAS unsigned char*)lds;
    unsigned char* ws = p.ws;
    const int lo = p.ph_lo, hi = p.ph_hi;
#define IN(k) (lo <= (k) && (k) < hi)
#ifndef SKIPMASK
#define SKIPMASK 0
#endif
#define SKIP(k) ((SKIPMASK >> (k)) & 1)
#define SEAM(k) do { if (IN(k) && IN((k) + 1)) grid.sync(); } while (0)
    bf16_t* const Hb = (bf16_t*)(ws + WS_H);
    float* const Yb = (float*)(ws + WS_Y);
    bf16_t* const ACT = (bf16_t*)(ws + WS_ACT);

    if (IN(0) && !SKIP(0)) {
        convert_w<1>(p.f1_w_in, D_, 2 * FF_, (bf16_t*)(ws + WS_WFIN), D_, 2 * FF_, (unsigned*)lds, bid, G);
        convert_w<0>(p.f1_w_out, FF_, D_, (bf16_t*)(ws + WS_WFOUT), FF_, D_, (unsigned*)lds, bid, G);
        convert_w<2>(p.w_in, D_, 9752, (bf16_t*)(ws + WS_WIN), D_, NVIN, (unsigned*)lds, bid, G);
        convert_w<0>(p.w_branch_sb, 1024, D_, (bf16_t*)(ws + WS_WSB), 1024, D_, (unsigned*)lds, bid, G);
        convert_w<0>(p.w_branch_nsa, 1024, D_, (bf16_t*)(ws + WS_WNSA), 1024, D_, (unsigned*)lds, bid, G);
        convert_w<0>(p.w_out, D_, D_, (bf16_t*)(ws + WS_WOUT), D_, D_, (unsigned*)lds, bid, G);
        convert_w<0>(p.cmp_k_w1, 4096, 128, (bf16_t*)(ws + WS_WC1K), 4096, 256, (unsigned*)lds, bid, G);
        convert_w<0>(p.cmp_v_w1, 4096, 128, (bf16_t*)(ws + WS_WC1V), 4096, 256, (unsigned*)lds, bid, G);
        convert_w<0>(p.cmp_k_w2, 128, 128, (bf16_t*)(ws + WS_WC2K), 256, 256, (unsigned*)lds, bid, G);
        convert_w<0>(p.cmp_v_w2, 128, 128, (bf16_t*)(ws + WS_WC2V), 256, 256, (unsigned*)lds, bid, G);
        if (bid == G - 1) cmp_bias(p.cmp_pos_k, p.cmp_k_w1, (float*)(ws + WS_BIAS), (float*)lds);
        if (bid == G - 2) cmp_bias(p.cmp_pos_v, p.cmp_v_w1, (float*)(ws + WS_BIAS) + 128, (float*)lds);
        rowwise<0>(p.x, nullptr, nullptr, Hb, nullptr, p.f1_pre_g, 1.0f, bid, G);
    }
    SEAM(0);
    if (IN(1) && !SKIP(1)) {
        pg8::Gemm g{Hb, (const bf16_t*)(ws + WS_WFIN), T_, 2 * FF_, D_, D_}; pg8::StaticOrder S; S.init(T_, 2 * FF_, G, bid);
        EpiSwiglu E{ACT};
        pg8::gemm_phase<EpiSwiglu, pg8::StaticOrder>(l3, g, S, E, nullptr);
    }
    SEAM(1);
    if (IN(2) && !SKIP(2)) {
        pg8::Gemm g{ACT, (const bf16_t*)(ws + WS_WFOUT), T_, D_, FF_, FF_}; pg8::StaticOrder S; S.init(T_, D_, G, bid);
        pg8::EpiF32 E{Yb, D_, nullptr};
        pg8::gemm_phase<pg8::EpiF32, pg8::StaticOrder>(l3, g, S, E, nullptr);
    }
    SEAM(2);
    if (IN(3) && !SKIP(3)) {
        rowwise<1>(Yb, p.x, p.out, Hb, p.f1_post_g, p.mix_pre_g, 0.5f, bid, G);
        convert_w<1>(p.f2_w_in, D_, 2 * FF_, (bf16_t*)(ws + WS_WFIN), D_, 2 * FF_, (unsigned*)lds, bid, G);
        convert_w<0>(p.f2_w_out, FF_, D_, (bf16_t*)(ws + WS_WFOUT), FF_, D_, (unsigned*)lds, bid, G);
    }
    SEAM(3);
    if (IN(4) && !SKIP(4)) {
        {
            pg8::Gemm g{Hb, (const bf16_t*)(ws + WS_WIN), T_, 8448, D_, D_}; pg8::StaticOrder S; S.init(T_, 8448, G, bid);
            EpiInprojA E{ws};
            pg8::gemm_phase<EpiInprojA, pg8::StaticOrder>(l3, g, S, E, nullptr);
        }
        {
            pg8::Gemm g{Hb, (const bf16_t*)(ws + WS_WIN) + (size_t)8448 * D_, T_, 1536, D_, D_}; pg8::StaticOrder S; S.init(T_, 1536, G, (bid + G - 64) % G);
            EpiInprojB E{ws};
            pg8::gemm_phase<EpiInprojB, pg8::StaticOrder>(l3, g, S, E, nullptr);
        }
    }
    SEAM(4);
    if (IN(5) && !SKIP(5)) {
        {
            pg8::Gemm g{(const bf16_t*)(ws + WS_KCK), (const bf16_t*)(ws + WS_WC1K), 2048, 256, 4096, 2048}; pg8::StaticOrder S; S.init(2048, 256, G, bid);
            EpiCmp1 E{(bf16_t*)(ws + WS_G1K), (const float*)(ws + WS_BIAS)};
            pg8::gemm_phase<EpiCmp1, pg8::StaticOrder>(l3, g, S, E, nullptr);
        }
        {
            pg8::Gemm g{(const bf16_t*)(ws + WS_KCV), (const bf16_t*)(ws + WS_WC1V), 2048, 256, 4096, 2048}; pg8::StaticOrder S; S.init(2048, 256, G, (bid + G - 8) % G);
            EpiCmp1 E{(bf16_t*)(ws + WS_G1V), (const float*)(ws + WS_BIAS) + 128};
            pg8::gemm_phase<EpiCmp1, pg8::StaticOrder>(l3, g, S, E, nullptr);
        }
        __syncthreads();
        for (int k = 0;; ++k) {
            const int idx = (k & 1) ? (k + 1) * G - 1 - bid : k * G + bid;
            if (k * G >= 512) break;
            if (idx >= 512 || idx < 0) continue;
            const int qblk = 15 - (idx >> 5), bh = idx & 31;
            sb_item(ws, lds, bh >> 3, bh & 7, qblk);
        }
    }
    SEAM(5);
    if (IN(6) && !SKIP(6)) {
        {
            pg8::Gemm g{(const bf16_t*)(ws + WS_G1K), (const bf16_t*)(ws + WS_WC2K), 2048, 256, 256, 256}; pg8::StaticOrder S; S.init(2048, 256, G, bid);
            EpiCmp2<0> E{(bf16_t*)(ws + WS_KC)};
            pg8::gemm_phase<EpiCmp2<0>, pg8::StaticOrder>(l3, g, S, E, nullptr);
        }
        {
            pg8::Gemm g{(const bf16_t*)(ws + WS_G1V), (const bf16_t*)(ws + WS_WC2V), 2048, 256, 256, 256}; pg8::StaticOrder S; S.init(2048, 256, G, (bid + G - 8) % G);
            EpiCmp2<1> E{(bf16_t*)(ws + WS_VCT)};
            pg8::gemm_phase<EpiCmp2<1>, pg8::StaticOrder>(l3, g, S, E, nullptr);
        }
    }
    SEAM(6);
    if (IN(7) && !SKIP(7)) {
        for (int k = 0;; ++k) {
            const int idx = (k & 1) ? (k + 1) * G - 1 - bid : k * G + bid;
            if (k * G >= 512) break;
            if (idx >= 512 || idx < 0) continue;
            const int qb = 63 - (idx >> 3), bg = idx & 7;
            nsa_item(ws, lds, bg >> 1, bg & 1, qb);
        }
    }
    SEAM(7);
    if (IN(8) && !SKIP(8)) {
        {
            pg8::Gemm g{(const bf16_t*)(ws + WS_QSB), (const bf16_t*)(ws + WS_WSB), T_, D_, 1024, 1024}; pg8::StaticOrder S; S.init(T_, D_, G, bid);
            EpiBranch<0> E{Hb, (const bf16_t*)(ws + WS_Y)};
            pg8::gemm_phase<EpiBranch<0>, pg8::StaticOrder>(l3, g, S, E, nullptr);
        }
        {
            pg8::Gemm g{(const bf16_t*)(ws + WS_QNSA), (const bf16_t*)(ws + WS_WNSA), T_, D_, 1024, 1024}; pg8::StaticOrder S; S.init(T_, D_, G, bid);
            EpiBranch<1> E{Hb, (const bf16_t*)(ws + WS_Y)};
            pg8::gemm_phase<EpiBranch<1>, pg8::StaticOrder>(l3, g, S, E, nullptr);
        }
    }
    SEAM(8);
    if (IN(9) && !SKIP(9)) {
        pg8::Gemm g{Hb, (const bf16_t*)(ws + WS_WOUT), T_, D_, D_, D_}; pg8::StaticOrder S; S.init(T_, D_, G, bid);
        pg8::EpiF32 E{Yb, D_, nullptr};
        pg8::gemm_phase<pg8::EpiF32, pg8::StaticOrder>(l3, g, S, E, nullptr);
    }
    SEAM(9);
    if (IN(10) && !SKIP(10)) rowwise<1>(Yb, p.out, p.out, Hb, p.mix_post_g, p.f2_pre_g, 1.0f, bid, G);
    SEAM(10);
    if (IN(11) && !SKIP(11)) {
        pg8::Gemm g{Hb, (const bf16_t*)(ws + WS_WFIN), T_, 2 * FF_, D_, D_}; pg8::StaticOrder S; S.init(T_, 2 * FF_, G, bid);
        EpiSwiglu E{ACT};
        pg8::gemm_phase<EpiSwiglu, pg8::StaticOrder>(l3, g, S, E, nullptr);
    }
    SEAM(11);
    if (IN(12) && !SKIP(12)) {
        pg8::Gemm g{ACT, (const bf16_t*)(ws + WS_WFOUT), T_, D_, FF_, FF_}; pg8::StaticOrder S; S.init(T_, D_, G, bid);
        pg8::EpiF32 E{Yb, D_, nullptr};
        pg8::gemm_phase<pg8::EpiF32, pg8::StaticOrder>(l3, g, S, E, nullptr);
    }
    SEAM(12);
    if (IN(13) && !SKIP(13)) rowwise<2>(Yb, p.out, p.out, nullptr, p.f2_post_g, nullptr, 0.5f, bid, G);
#undef IN
#undef SEAM
}

extern "C" void kernel_launch(void* const* d_in, const int* in_sizes, int n_in, void* d_out, int out_size, void* d_ws, size_t ws_size, hipStream_t stream) {
    static int grid = 0;
    if (grid == 0) {
        if (n_in != 21 || ws_size < mk::WS_END) { fprintf(stderr, "kernel_launch: unexpected n_in %d or ws_size %zu (need %zu)\n", n_in, ws_size, (size_t)mk::WS_END); grid = -1; return; }
        int dev = 0, cus = 0, per_cu = 0;
        hipGetDevice(&dev);
        hipDeviceGetAttribute(&cus, hipDeviceAttributeMultiprocessorCount, dev);
        if (hipFuncSetAttribute((const void*)mega_fwd, hipFuncAttributeMaxDynamicSharedMemorySize, mk::LDS_BYTES) != hipSuccess) { fprintf(stderr, "kernel_launch: hipFuncSetAttribute failed\n"); grid = -1; return; }
        if (hipOccupancyMaxActiveBlocksPerMultiprocessor(&per_cu, (const void*)mega_fwd, 512, mk::LDS_BYTES) != hipSuccess || per_cu < 1) { (void)hipGetLastError(); per_cu = 1; }
        grid = cus * per_cu;
        fprintf(stderr, "kernel_launch: grid %d (cus %d per_cu %d) ws %zu\n", grid, cus, per_cu, ws_size);
    }
    if (grid < 0) return;
    Params p{};
    const float** f = (const float**)&p;
    for (int i = 0; i < 21; ++i) f[i] = (const float*)d_in[i];
    p.out = (float*)d_out; p.ws = (unsigned char*)d_ws; p.ph_lo = 0; p.ph_hi = 14;
    void* args[] = {&p};
    hipError_t e = hipLaunchCooperativeKernel((const void*)mega_fwd, dim3(grid), dim3(512), args, mk::LDS_BYTES, stream);
    if (e != hipSuccess) fprintf(stderr, "cooperative launch failed: %s (grid %d)\n", hipGetErrorString(e), grid);
}
```

```cpp
#include <hip/hip_runtime.h>
#include <hip/hip_cooperative_groups.h>
#include <cstdio>
namespace cg = cooperative_groups;

#define XB_TMO      128
#define XB_XCNT(j)  (256  + 64 * (j))
#define XB_XSUB(j)  (1280 + 64 * (j))
#define XB_XGEN(j)  (2304 + 64 * (j))
#define XB_TOP      3328
#define XB_TOPGEN   3392
#define XCD_BAR_WORDS 3456
#define XB_SPIN_CAP (1u << 18)
#define XB_LAS __attribute__((address_space(3)))

__device__ __forceinline__ unsigned xb_ld(unsigned* p)              { return __hip_atomic_load(p, __ATOMIC_RELAXED, __HIP_MEMORY_SCOPE_AGENT); }
__device__ __forceinline__ unsigned xb_add(unsigned* p, unsigned v) { return __hip_atomic_fetch_add(p, v, __ATOMIC_RELAXED, __HIP_MEMORY_SCOPE_AGENT); }
__device__ __forceinline__ unsigned xb_xcc_id() { return (unsigned)__builtin_amdgcn_s_getreg((3 << 11) | 20) & 0xFu; }
#define XB_SPIN(cond, bar) do { unsigned _sp = 0; while (cond) { __builtin_amdgcn_s_sleep(1); \
    if ((++_sp & 255u) == 0u) { if (xb_ld(&(bar)[XB_TMO])) break; if (_sp > XB_SPIN_CAP) { atomicAdd(&(bar)[XB_TMO], 1u); break; } } } } while (0)

struct XcdBarrier {
    unsigned* bar; unsigned x;
    volatile XB_LAS unsigned* st;
};

__device__ __forceinline__ XcdBarrier xcd_barrier_post(unsigned* bar, volatile XB_LAS unsigned* st) {
    XcdBarrier b; b.bar = bar; b.x = xb_xcc_id(); b.st = st;
    if (threadIdx.x == 0) (void)xb_add(&bar[XB_XCNT(b.x)], 1u);
    return b;
}
__device__ __forceinline__ void xcd_barrier_complete(unsigned* bar, unsigned x, unsigned& nloc, unsigned& nx) {
    const unsigned G = gridDim.x * gridDim.y * gridDim.z;
    unsigned sum, cnt, mine, sp = 0u;
    for (;;) {
        sum = 0u; cnt = 0u; mine = 0u;
#pragma unroll
        for (unsigned j = 0; j < 16; ++j) { const unsigned c = xb_ld(&bar[XB_XCNT(j)]); sum += c; cnt += (c > 0u) ? 1u : 0u; mine = (j == x) ? c : mine; }
        if (sum == G) break;
        __builtin_amdgcn_s_sleep(1);
        if ((++sp & 255u) == 0u) { if (xb_ld(&bar[XB_TMO])) break; if (sp > XB_SPIN_CAP) { atomicAdd(&bar[XB_TMO], 1u); break; } }
    }
    nloc = mine > 0u ? mine : 1u; nx = cnt > 0u ? cnt : 1u;
}

__device__ __forceinline__ void xcd_barrier(const XcdBarrier& b) {
    asm volatile("s_waitcnt vmcnt(0)" ::: "memory");
    __syncthreads();
    if (threadIdx.x == 0) {
        unsigned* bar = b.bar;
        __builtin_amdgcn_s_waitcnt(0);
        unsigned nloc = b.st[0], nx = b.st[1];
        if (nloc == 0u) { xcd_barrier_complete(bar, b.x, nloc, nx); b.st[0] = nloc; b.st[1] = nx; }
        const unsigned old = xb_add(&bar[XB_XSUB(b.x)], 1u);
        const unsigned gen = old / nloc;
        if (old + 1u == (gen + 1u) * nloc) {
            __builtin_amdgcn_fence(__ATOMIC_RELEASE, "agent");
            asm volatile("s_waitcnt vmcnt(0)" ::: "memory");
            const unsigned og = xb_add(&bar[XB_TOP], 1u);
            const unsigned tg = og / nx;
            if (og + 1u == (tg + 1u) * nx) xb_add(&bar[XB_TOPGEN], 1u);
            else XB_SPIN(xb_ld(&bar[XB_TOPGEN]) == tg, bar);
            __builtin_amdgcn_fence(__ATOMIC_ACQUIRE, "agent");
            xb_add(&bar[XB_XGEN(b.x)], 1u);
            asm volatile("s_waitcnt vmcnt(0)" ::: "memory");
        } else {
            XB_SPIN(xb_ld(&bar[XB_XGEN(b.x)]) == gen, bar);
            __builtin_amdgcn_fence(__ATOMIC_ACQUIRE, "agent");
            asm volatile("s_waitcnt vmcnt(0)" ::: "memory");
        }
    }
    __syncthreads();
}


namespace pg8 {
#define PG8_LAS __attribute__((address_space(3)))
typedef unsigned short bf16_t;
typedef short bf16x8 __attribute__((ext_vector_type(8)));
typedef float f32x4 __attribute__((ext_vector_type(4)));
typedef unsigned u32x4 __attribute__((ext_vector_type(4)));
constexpr int BM = 256, BK = 64, HALF = 128, HTB = HALF * BK * 2  , STAGE_BYTES = 8 * HTB, NXCD = 8, WGM = 8;

__host__ __device__ __forceinline__ int lds_byte(int r, int c) { const int st = (r >> 4) * 2 + (c >> 5), rr = r & 15, cc = c & 31, ob = rr * 64 + cc * 2; return st * 1024 + (ob ^ (((ob >> 9) & 1) << 5)); }
__host__ __device__ __forceinline__ void stage_rc(int b, int& R, int& C) { const int st = b / 1024, sb = b % 1024, swz = sb ^ (((sb >> 9) & 1) << 5); R = (st >> 1) * 16 + swz / 64; C = (st & 1) * 32 + (swz % 64) / 2; }
__host__ __device__ __forceinline__ int perm32(int rho) { const int n = rho >> 4, i = rho & 15; return 8 * (i >> 2) + 4 * n + (i & 3); }

struct Unit { int pm, pn; };
struct Gemm { const bf16_t* A; const bf16_t* Bt; int M, N, K, lda; int ldb = 0; };

struct StaticOrder {
    int nM, nN, nwg, G, c;
    __host__ __device__ void init(int M, int N, int G_, int c_) { nM = M / BM; nN = N / BM; nwg = nM * nN; G = G_; c = c_; }
    __host__ __device__ bool next(int i, Unit& u) const {
        const long L = (long)i * G + c; if (L >= nwg) return false;
        int wgid = (int)L; { const int q = nwg / NXCD, r = nwg % NXCD, xcd = wgid % NXCD, off = wgid / NXCD; wgid = (xcd < r ? xcd * (q + 1) : r * (q + 1) + (xcd - r) * q) + off; }
        const int nig = WGM * nN, gid = wgid / nig, fm = gid * WGM, gsz = (nM - fm) < WGM ? (nM - fm) : WGM;
        u.pm = fm + ((wgid % nig) % gsz); u.pn = (wgid % nig) / gsz; return true;
    }
    __device__ __forceinline__ void a_ready(const Unit&) const {}
    __device__ __forceinline__ void done(const Unit&) const {}
};
struct CountedOrder : StaticOrder {
    const unsigned* ready; unsigned need; unsigned* tmo;
    __device__ __forceinline__ void a_ready(const Unit& u) const {
        if (threadIdx.x < 64) {
            const unsigned long long t0 = __builtin_amdgcn_s_memrealtime(); unsigned polls = 0;
            while ((unsigned)__builtin_amdgcn_readfirstlane(__hip_atomic_load(ready + 64 * u.pm, __ATOMIC_RELAXED, __HIP_MEMORY_SCOPE_AGENT)) < need) {
                if ((++polls & 255u) == 0u && __builtin_amdgcn_readfirstlane(__hip_atomic_load(tmo, __ATOMIC_RELAXED, __HIP_MEMORY_SCOPE_AGENT)) != 0u) break;
                if (__builtin_amdgcn_s_memrealtime() - t0 > 2000000ull) {
                    if (threadIdx.x == 0) { unsigned expect = 0u; __hip_atomic_compare_exchange_strong(tmo + 1, &expect, 0x600u | (unsigned)(u.pm & 0xff), __ATOMIC_RELAXED, __ATOMIC_RELAXED, __HIP_MEMORY_SCOPE_AGENT); __hip_atomic_store(tmo, 1u, __ATOMIC_RELAXED, __HIP_MEMORY_SCOPE_AGENT); }
                    break; }
                __builtin_amdgcn_s_sleep(2); }
            __builtin_amdgcn_fence(__ATOMIC_ACQUIRE, "agent");
            asm volatile("s_waitcnt vmcnt(0)" ::: "memory");
        }
#if !defined(BROKEN_HOOK_NO_BARRIER)
        asm volatile("" ::: "memory"); __builtin_amdgcn_s_barrier(); asm volatile("" ::: "memory");
#endif
    }
};

__device__ __forceinline__ unsigned cvt_pk_bf16(float lo, float hi) { unsigned r; asm volatile("v_cvt_pk_bf16_f32 %0, %1, %2" : "=v"(r) : "v"(lo), "v"(hi)); return r; }
typedef float f32x2 __attribute__((ext_vector_type(2)));
__device__ __forceinline__ f32x2 gelu_pk(f32x2 v) {
    const f32x2 av = __builtin_elementwise_abs(v), d = av * 0.2316418882f + 1.0f;
    f32x2 t; t.x = __builtin_amdgcn_rcpf(d.x); t.y = __builtin_amdgcn_rcpf(d.y);
    f32x2 q = t * 0.5307027145f + (-0.7265760135f); q = q * t + 0.7107068705f; q = q * t + (-0.142248368f); q = q * t + 0.127414796f; q = q * t;
    const f32x2 s = (v * v) * (-0.72134752044f);
    f32x2 e; e.x = __builtin_amdgcn_exp2f(s.x); e.y = __builtin_amdgcn_exp2f(s.y);
    const f32x2 m = v * (q * e), r = v - m;
    f32x2 o; o.x = v.x < 0.f ? m.x : r.x; o.y = v.y < 0.f ? m.y : r.y; return o;
}

struct EpiF32 {
    static constexpr bool PERM = false, AFTER_DRAIN = false;
    float* C; int ldc; const float* bias;
    __device__ __forceinline__ void operator()(const f32x4 (&acc)[2][2][4][2], const Unit& u, int wr, int wc, int fr, int fq) const {
        const int row0 = u.pm * BM + wr * 64 + fr, col0 = u.pn * BM + wc * 32 + 4 * fq;
        f32x4 bv[2][2];
#pragma unroll
        for (int bj = 0; bj < 2; ++bj)
#pragma unroll
            for (int n = 0; n < 2; ++n) bv[bj][n] = bias ? *(const f32x4*)(bias + col0 + bj * HALF + n * 16) : (f32x4){0.f, 0.f, 0.f, 0.f};
#pragma unroll
        for (int ai = 0; ai < 2; ++ai)
#pragma unroll
            for (int m = 0; m < 4; ++m) { float* rowp = C + (size_t)(row0 + ai * HALF + m * 16) * ldc + col0;
#pragma unroll
                for (int bj = 0; bj < 2; ++bj)
#pragma unroll
                    for (int n = 0; n < 2; ++n) *(f32x4*)(rowp + bj * HALF + n * 16) = acc[ai][bj][m][n] + bv[bj][n]; }
    }
};
template <int ACT  > struct EpiBf16 {
    static constexpr bool PERM = true, AFTER_DRAIN = false;
    bf16_t* O; int ldc; const float* bias; int split_cols; size_t split_stride;
    __device__ __forceinline__ void operator()(const f32x4 (&acc)[2][2][4][2], const Unit& u, int wr, int wc, int fr, int fq) const {
        const int row0 = u.pm * BM + wr * 64 + fr; int colt = u.pn * BM; bf16_t* base = O;
        if (split_cols) { const int t = colt / split_cols; base += (size_t)t * split_stride; colt -= t * split_cols; }
        const int col0 = colt + wc * 32 + 8 * fq, bcol0 = u.pn * BM + wc * 32 + 8 * fq;
        f32x4 bv[2][2];
#pragma unroll
        for (int bj = 0; bj < 2; ++bj)
#pragma unroll
            for (int n = 0; n < 2; ++n) bv[bj][n] = bias ? *(const f32x4*)(bias + bcol0 + bj * HALF + 4 * n) : (f32x4){0.f, 0.f, 0.f, 0.f};
#pragma unroll
        for (int ai = 0; ai < 2; ++ai)
#pragma unroll
            for (int m = 0; m < 4; ++m) { bf16_t* rowp = base + (size_t)(row0 + ai * HALF + m * 16) * ldc + col0;
#pragma unroll
                for (int bj = 0; bj < 2; ++bj) { f32x4 v0 = acc[ai][bj][m][0] + bv[bj][0], v1 = acc[ai][bj][m][1] + bv[bj][1];
                    if (ACT == 1) { f32x2 a = gelu_pk((f32x2){v0[0], v0[1]}), b = gelu_pk((f32x2){v0[2], v0[3]}), c = gelu_pk((f32x2){v1[0], v1[1]}), d = gelu_pk((f32x2){v1[2], v1[3]});
                        v0 = (f32x4){a.x, a.y, b.x, b.y}; v1 = (f32x4){c.x, c.y, d.x, d.y}; }
                    if (ACT == 2) {
#pragma unroll
                        for (int j = 0; j < 4; ++j) { v0[j] = 0.5f * v0[j] * (1.0f + erff(v0[j] * 0.70710678f)); v1[j] = 0.5f * v1[j] * (1.0f + erff(v1[j] * 0.70710678f)); } }
                    u32x4 w; w.x = cvt_pk_bf16(v0[0], v0[1]); w.y = cvt_pk_bf16(v0[2], v0[3]); w.z = cvt_pk_bf16(v1[0], v1[1]); w.w = cvt_pk_bf16(v1[2], v1[3]);
                    *(u32x4*)(rowp + bj * HALF) = w; } }
    }
};

template <class Epi, class Sched, bool ALIGN_EPI = false, bool SP2 = false>
__device__ __forceinline__ void gemm_phase(PG8_LAS unsigned char* lds, const Gemm g, const Sched& S, const Epi& E) {
    const int tid = threadIdx.x, wid = __builtin_amdgcn_readfirstlane(tid >> 6), lane = tid & 63, wr = wid >> 2, wc = wid & 3, fr = lane & 15, fq = lane >> 4;
    const int K = g.K, nt = K / BK; const int LDB = g.ldb ? g.ldb : g.K;
    unsigned voffA[2], voffB[2];
#pragma unroll
    for (int i = 0; i < 2; ++i) { int R, C; stage_rc(tid * 16 + i * 8192, R, C); const int Rb = Epi::PERM ? ((R & ~31) + perm32(R & 31)) : R;
        voffA[i] = (unsigned)(R * g.lda + C) * 2u; voffB[i] = (unsigned)(Rb * LDB + C) * 2u; }
    const size_t kstep = (size_t)(BK * 2);
    const size_t hstep = (size_t)HALF * LDB * 2;
    const size_t tstep = 2 * hstep; const size_t hstepA = (size_t)HALF * g.lda * 2; const size_t tstepA = 2 * hstepA;
    const unsigned ldsw = (unsigned)wid * 1024u;
    const int aoff = lds_byte(wr * 64 + fr, fq * 8), boff = lds_byte(wc * 32 + fr, fq * 8);
#define PG8_SA(b, h) (((b) * 2 + (h)) * HTB)
#define PG8_SB(b, h) ((4 + (b) * 2 + (h)) * HTB)
#define PG8_STAGE(bufoff, gbase, voff) do { _Pragma("unroll") for (int _i = 0; _i < 2; ++_i) \
        __builtin_amdgcn_global_load_lds((const unsigned*)((const char*)(gbase) + (voff)[_i]), (PG8_LAS unsigned*)(lds + (bufoff) + ldsw + _i * 8192), 16, 0, 0); } while (0)
#define PG8_LDA(dst, b, h) do { _Pragma("unroll") for (int m = 0; m < 4; ++m) _Pragma("unroll") for (int k = 0; k < 2; ++k) dst[m][k] = *(const PG8_LAS bf16x8*)(lds + PG8_SA(b, h) + aoff + m * 2048 + k * 1024); } while (0)
#define PG8_LDB(dst, b, h) do { _Pragma("unroll") for (int n = 0; n < 2; ++n) _Pragma("unroll") for (int k = 0; k < 2; ++k) dst[n][k] = *(const PG8_LAS bf16x8*)(lds + PG8_SB(b, h) + boff + n * 2048 + k * 1024); } while (0)
#define PG8_MMA(ai, bj, At, Bt) do { __builtin_amdgcn_s_setprio(1); _Pragma("unroll") for (int m = 0; m < 4; ++m) _Pragma("unroll") for (int n = 0; n < 2; ++n) _Pragma("unroll") for (int k = 0; k < 2; ++k) \
        acc[ai][bj][m][n] = __builtin_amdgcn_mfma_f32_16x16x32_bf16(Bt[n][k], At[m][k], acc[ai][bj][m][n], 0, 0, 0); __builtin_amdgcn_s_setprio(0); } while (0)
#define PG8_WAIT_V(n) asm volatile("s_waitcnt vmcnt(" #n ")" ::: "memory")
#define PG8_WAIT_L(n) asm volatile("s_waitcnt lgkmcnt(" #n ")" ::: "memory")
#define PG8_BAR __builtin_amdgcn_s_barrier()
#define PG8_SCHED __builtin_amdgcn_sched_barrier(0)
    Unit cur, nxt; int ui = 0;
    if (!S.next(0, cur)) return;
    f32x4 acc[2][2][4][2];
#pragma unroll
    for (int a = 0; a < 2; ++a)
#pragma unroll
        for (int b = 0; b < 2; ++b)
#pragma unroll
            for (int m = 0; m < 4; ++m)
#pragma unroll
                for (int n = 0; n < 2; ++n) acc[a][b][m][n] = (f32x4){0.f, 0.f, 0.f, 0.f};
    bf16x8 At[4][2], B0[2][2], B1[2][2];
    const char* cA = (const char*)g.A + (size_t)cur.pm * tstepA; const char* cB = (const char*)g.Bt + (size_t)cur.pn * tstep;
    S.a_ready(cur);
    if constexpr (SP2) {
        PG8_STAGE(PG8_SB(0, 0), cB, voffB); PG8_STAGE(PG8_SB(0, 1), cB + hstep, voffB); PG8_STAGE(PG8_SA(0, 0), cA, voffA); PG8_STAGE(PG8_SA(0, 1), cA + hstepA, voffA);
        if (wr == 1) PG8_BAR;
        PG8_WAIT_V(2); PG8_BAR;
        PG8_STAGE(PG8_SB(1, 0), cB + kstep, voffB); PG8_STAGE(PG8_SA(1, 0), cA + kstep, voffA); PG8_STAGE(PG8_SB(1, 1), cB + hstep + kstep, voffB);
        PG8_WAIT_V(6); PG8_BAR;
    } else {
        PG8_STAGE(PG8_SB(0, 0), cB, voffB); PG8_STAGE(PG8_SA(0, 0), cA, voffA); PG8_STAGE(PG8_SB(0, 1), cB + hstep, voffB); PG8_STAGE(PG8_SA(0, 1), cA + hstepA, voffA);
        if (wr == 1) PG8_BAR;
        PG8_WAIT_V(4); PG8_BAR;
        PG8_STAGE(PG8_SB(1, 0), cB + kstep, voffB); PG8_STAGE(PG8_SA(1, 0), cA + kstep, voffA); PG8_STAGE(PG8_SB(1, 1), cB + hstep + kstep, voffB);
        PG8_WAIT_V(6); PG8_BAR;
    }
    for (;;) {
        const bool has_next = S.next(ui + 1, nxt);
        const char* nA = has_next ? (const char*)g.A + (size_t)nxt.pm * tstepA : cA; const char* nB = has_next ? (const char*)g.Bt + (size_t)nxt.pn * tstep : cB;
        for (int t = 0; t < nt; t += 2) {
            const bool last = (t == nt - 2);
            const char* a1 = cA + (size_t)(t + 1) * kstep;
            const char* a2 = last ? nA : cA + (size_t)(t + 2) * kstep; const char* b2 = last ? nB : cB + (size_t)(t + 2) * kstep;
            const char* a3 = a2 + kstep; const char* b3 = b2 + kstep;
            if (last && has_next) S.a_ready(nxt);
            if constexpr (SP2) {
            PG8_LDB(B0, 0, 0); PG8_LDB(B1, 0, 1); PG8_SCHED; PG8_LDA(At, 0, 0); PG8_STAGE(PG8_SA(1, 1), a1 + hstepA, voffA);
            PG8_WAIT_V(8); PG8_WAIT_L(0); PG8_BAR; PG8_MMA(0, 0, At, B0); PG8_MMA(0, 1, At, B1); PG8_BAR; PG8_SCHED;
            PG8_LDA(At, 0, 1); PG8_STAGE(PG8_SB(0, 0), b2, voffB); PG8_STAGE(PG8_SB(0, 1), b2 + hstep, voffB); PG8_STAGE(PG8_SA(0, 0), a2, voffA);
            PG8_WAIT_V(8); PG8_WAIT_L(0); PG8_BAR; PG8_MMA(1, 0, At, B0); PG8_MMA(1, 1, At, B1); PG8_BAR; PG8_SCHED;
            PG8_LDB(B0, 1, 0); PG8_LDB(B1, 1, 1); PG8_SCHED; PG8_LDA(At, 1, 0); PG8_STAGE(PG8_SA(0, 1), a2 + hstepA, voffA);
            PG8_WAIT_V(8); PG8_WAIT_L(0); PG8_BAR; PG8_MMA(0, 0, At, B0); PG8_MMA(0, 1, At, B1); PG8_BAR; PG8_SCHED;
            PG8_LDA(At, 1, 1); PG8_STAGE(PG8_SB(1, 0), b3, voffB); PG8_STAGE(PG8_SB(1, 1), b3 + hstep, voffB); PG8_STAGE(PG8_SA(1, 0), a3, voffA);
            PG8_WAIT_V(8); PG8_WAIT_L(0); PG8_BAR; PG8_MMA(1, 0, At, B0); PG8_MMA(1, 1, At, B1); PG8_BAR; PG8_SCHED;
            } else {
            PG8_LDB(B0, 0, 0); PG8_SCHED; PG8_LDA(At, 0, 0); PG8_STAGE(PG8_SA(1, 1), a1 + hstepA, voffA);
            PG8_WAIT_L(8); PG8_BAR; PG8_WAIT_L(0); PG8_MMA(0, 0, At, B0); PG8_BAR; PG8_SCHED;
            PG8_LDB(B1, 0, 1); PG8_STAGE(PG8_SB(0, 0), b2, voffB);
            PG8_BAR; PG8_WAIT_L(0); PG8_MMA(0, 1, At, B1); PG8_BAR;
            PG8_LDA(At, 0, 1); PG8_STAGE(PG8_SA(0, 0), a2, voffA);
            PG8_BAR; PG8_WAIT_L(0); PG8_MMA(1, 0, At, B0); PG8_BAR; PG8_SCHED;
            PG8_STAGE(PG8_SB(0, 1), b2 + hstep, voffB);
            PG8_WAIT_V(6); PG8_BAR; PG8_MMA(1, 1, At, B1); PG8_BAR;
            PG8_LDB(B0, 1, 0); PG8_SCHED; PG8_LDA(At, 1, 0); PG8_STAGE(PG8_SA(0, 1), a2 + hstepA, voffA);
            PG8_WAIT_L(8); PG8_BAR; PG8_WAIT_L(0); PG8_MMA(0, 0, At, B0); PG8_BAR; PG8_SCHED;
            PG8_LDB(B1, 1, 1); PG8_STAGE(PG8_SB(1, 0), b3, voffB);
            PG8_BAR; PG8_WAIT_L(0); PG8_MMA(0, 1, At, B1); PG8_BAR;
            PG8_LDA(At, 1, 1); PG8_STAGE(PG8_SA(1, 0), a3, voffA);
            PG8_BAR; PG8_WAIT_L(0); PG8_MMA(1, 0, At, B0); PG8_BAR; PG8_SCHED;
            PG8_STAGE(PG8_SB(1, 1), b3 + hstep, voffB);
            PG8_WAIT_V(6); PG8_BAR; PG8_MMA(1, 1, At, B1); PG8_BAR;
            }
        }
        if constexpr (ALIGN_EPI) { if (wr == 0) PG8_BAR; }
        if constexpr (!Epi::AFTER_DRAIN) { E(acc, cur, wr, wc, fr, fq); S.done(cur); }
        if (!has_next) break;
#pragma unroll
        for (int a = 0; a < 2; ++a)
#pragma unroll
            for (int b = 0; b < 2; ++b)
#pragma unroll
                for (int m = 0; m < 4; ++m)
#pragma unroll
                    for (int n = 0; n < 2; ++n) acc[a][b][m][n] = (f32x4){0.f, 0.f, 0.f, 0.f};
        cur = nxt; cA = nA; cB = nB; ++ui;
        if constexpr (ALIGN_EPI) { if (wr == 1) PG8_BAR; }
    }
    PG8_WAIT_V(0);
    if constexpr (!ALIGN_EPI) { if (wr == 0) PG8_BAR; }
    PG8_BAR;
    if constexpr (Epi::AFTER_DRAIN) { E.fused(acc, cur, wr, wc, fr, fq, lds, wid, lane); S.done(cur); }
#undef PG8_SA
#undef PG8_SB
#undef PG8_STAGE
#undef PG8_LDA
#undef PG8_LDB
#undef PG8_MMA
#undef PG8_WAIT_V
#undef PG8_WAIT_L
#undef PG8_BAR
#undef PG8_SCHED
}
}
namespace mk {
typedef unsigned short bf16_t;
typedef short bf16x8 __attribute__((ext_vector_type(8)));
typedef short s16x4 __attribute__((ext_vector_type(4)));
typedef float f32x16 __attribute__((ext_vector_type(16)));
typedef float f32x4 __attribute__((ext_vector_type(4)));
typedef unsigned u32x4 __attribute__((ext_vector_type(4)));
typedef unsigned u32x2 __attribute__((ext_vector_type(2)));
#define DI __device__ __forceinline__

constexpr int B_ = 4, S_ = 4096, T_ = B_ * S_, D_ = 2048, FF_ = 5632, NVIN = 9984;
constexpr int NTHREADS = 512;
constexpr float EPS = 1e-6f;
constexpr float LOG2E = 1.4426950408889634f;
constexpr float QSCALE = 0.08838834764831845f;

constexpr size_t al(size_t x) { return (x + 4095) & ~(size_t)4095; }
constexpr size_t WS_WFIN = 0;
constexpr size_t WS_WFOUT = WS_WFIN + al((size_t)2 * FF_ * D_ * 2);
constexpr size_t WS_WIN = WS_WFOUT + al((size_t)D_ * FF_ * 2);
constexpr size_t WS_WSB = WS_WIN + al((size_t)NVIN * D_ * 2);
constexpr size_t WS_WNSA = WS_WSB + al((size_t)D_ * 1024 * 2);
constexpr size_t WS_WOUT = WS_WNSA + al((size_t)D_ * 1024 * 2);
constexpr size_t WS_WC1K = WS_WOUT + al((size_t)D_ * D_ * 2);
constexpr size_t WS_WC1V = WS_WC1K + al((size_t)256 * 4096 * 2);
constexpr size_t WS_WC2K = WS_WC1V + al((size_t)256 * 4096 * 2);
constexpr size_t WS_WC2V = WS_WC2K + al((size_t)256 * 256 * 2);
constexpr size_t WS_BIAS = WS_WC2V + al((size_t)256 * 256 * 2);
constexpr size_t WS_BAR = WS_BIAS + 16384;
#ifndef WS_SHIFT
#define WS_SHIFT 0
#endif
constexpr size_t WS_H = WS_BAR + 16384 + (size_t)WS_SHIFT;
constexpr size_t WS_Y = WS_H + al((size_t)T_ * D_ * 2);
constexpr size_t WS_ACT = WS_Y + al((size_t)T_ * D_ * 4);
constexpr size_t WS_QSB = WS_ACT;
constexpr size_t WS_KSB = WS_QSB + (size_t)T_ * 1024 * 2;
constexpr size_t WS_VTSB = WS_KSB + (size_t)T_ * 1024 * 2;
constexpr size_t WS_QNSA = WS_VTSB + (size_t)T_ * 1024 * 2;
constexpr size_t WS_KCK = WS_QNSA + (size_t)T_ * 1024 * 2;
constexpr size_t WS_KCV = WS_KCK + (size_t)T_ * 256 * 2 + 65536;
constexpr size_t WS_KSLC = WS_KCV + (size_t)T_ * 256 * 2 + 65536;
constexpr size_t WS_VTSLC = WS_KSLC + (size_t)T_ * 256 * 2;
constexpr size_t WS_KWIN = WS_VTSLC + (size_t)T_ * 256 * 2;
constexpr size_t WS_VTWIN = WS_KWIN + (size_t)T_ * 256 * 2;
constexpr size_t WS_GN = WS_VTWIN + (size_t)T_ * 256 * 2;
constexpr size_t WS_G1K = WS_GN + (size_t)T_ * 32 * 4;
constexpr size_t WS_G1V = WS_G1K + (size_t)2048 * 256 * 2;
constexpr size_t WS_KC = WS_G1V + (size_t)2048 * 256 * 2;
constexpr size_t WS_VCT = WS_KC + (size_t)2048 * 128 * 2;
constexpr size_t WS_CPART = WS_VCT + (size_t)2048 * 128 * 2;
constexpr size_t WS_MIXEND = WS_CPART + (size_t)8 * 2048 * 128 * 4;
constexpr size_t WS_ACTEND = WS_ACT + al((size_t)T_ * FF_ * 2);
constexpr size_t WS_RS2 = (WS_MIXEND > WS_ACTEND ? WS_MIXEND : WS_ACTEND) + 4096;
constexpr size_t WS_RS3 = WS_RS2 + (size_t)T_ * 4;
constexpr size_t WS_END = WS_RS3 + (size_t)T_ * 4 + 4096;
static_assert(WS_END <= (size_t)536870912, "workspace too large");

constexpr int LDS_BYTES = 132096;

struct Params {
    const float* x; const float* f1_pre_g; const float* f1_w_in; const float* f1_w_out; const float* f1_post_g;
    const float* mix_pre_g; const float* w_in; const float* cmp_pos_k; const float* cmp_k_w1; const float* cmp_k_w2;
    const float* cmp_pos_v; const float* cmp_v_w1; const float* cmp_v_w2; const float* w_branch_sb; const float* w_branch_nsa;
    const float* w_out; const float* mix_post_g; const float* f2_pre_g; const float* f2_w_in; const float* f2_w_out; const float* f2_post_g;
    float* out; unsigned char* ws; unsigned phmask, pad;
};

typedef __bf16 hwbf16x2 __attribute__((ext_vector_type(2)));
typedef float f32x2v __attribute__((ext_vector_type(2)));
DI unsigned pk2(float a, float b) {
    f32x2v v; v.x = a; v.y = b;
    return __builtin_bit_cast(unsigned, __builtin_convertvector(v, hwbf16x2));
}
DI bf16_t f2bf(float a) { unsigned ua = __float_as_uint(a); ua += 0x7fffu + ((ua >> 16) & 1u); return (bf16_t)(ua >> 16); }
DI float bf2f(bf16_t v) { return __uint_as_float(((unsigned)v) << 16); }
DI float wave_sum(float v) {
#pragma unroll
    for (int o = 32; o >= 1; o >>= 1) v += __shfl_xor(v, o);
    return v;
}
DI float sigmoidf_(float x) { return __builtin_amdgcn_rcpf(1.0f + __expf(-x)); }

template <int MAP> DI int map_col(int nv, int Nact) {
    if (MAP == 0) return nv < Nact ? nv : -1;
    if (MAP == 1) { const int p = nv >> 8, hh = (nv >> 7) & 1, i = nv & 127; return hh * FF_ + 128 * p + i; }
    if (nv < 2048) return nv;
    if (nv < 3584) return nv + 1024;
    if (nv < 3840) return 4608 + (nv - 3584);
    if (nv < 4096) return 5120 + (nv - 3840);
    if (nv < 8192) return 5656 + (nv - 4096);
    if (nv < 8216) return 5632 + (nv - 8192);
    if (nv < 8448) return -1;
    if (nv < 9472) return 2048 + (nv - 8448);
    if (nv < 9728) return 4864 + (nv - 9472);
    return 5376 + (nv - 9728);
}
template <int MAP> DI void convert_w(const float* __restrict__ W, int Kact, int Nact, bf16_t* __restrict__ Bt, int Kv, int Nv, unsigned* lds32, int bid, int G, const float* __restrict__ gk = nullptr, int t0 = 0, int t1 = -1) {
    const int tid = threadIdx.x;
    const int tk = Kv >> 7, tn = Nv >> 6, ntile = (t1 < 0) ? tk * tn : t1;
    const int n4 = (tid & 15) * 4, kq = tid >> 4;
    bid += t0;
    f32x4 va[2], vb[2];
    auto load_tile = [&](int tile) {
        const int n0 = (tile / tk) << 6, k0 = (tile % tk) << 7;
        const int col = map_col<MAP>(n0 + n4, Nact);
#pragma unroll
        for (int i = 0; i < 2; ++i) {
            const int k = k0 + 2 * (kq + 32 * i);
            va[i] = (f32x4){0.f, 0.f, 0.f, 0.f}; vb[i] = va[i];
            if (col >= 0 && k < Kact) { va[i] = __builtin_nontemporal_load((const f32x4*)(W + (size_t)k * Nact + col)); vb[i] = __builtin_nontemporal_load((const f32x4*)(W + (size_t)(k + 1) * Nact + col));
                if (gk) { va[i] *= gk[k]; vb[i] *= gk[k + 1]; } }
        }
    };
    if (bid < ntile) load_tile(bid);
    for (int tile = bid; tile < ntile; tile += G) {
        const int n0 = (tile / tk) << 6, k0 = (tile % tk) << 7;
#pragma unroll
        for (int i = 0; i < 2; ++i)
#pragma unroll
            for (int j = 0; j < 4; ++j) lds32[(n4 + j) * 65 + kq + 32 * i] = pk2(va[i][j], vb[i][j]);
        if (tile + G < ntile) load_tile(tile + G);
        __syncthreads();
#pragma unroll
        for (int i = 0; i < 2; ++i) {
            const int c = tid + 512 * i, row = c >> 4, ch = c & 15;
            u32x4 v; v.x = lds32[row * 65 + ch * 4 + 0]; v.y = lds32[row * 65 + ch * 4 + 1]; v.z = lds32[row * 65 + ch * 4 + 2]; v.w = lds32[row * 65 + ch * 4 + 3];
            *(u32x4*)(Bt + (size_t)(n0 + row) * Kv + k0 + ch * 8) = v;
        }
        __syncthreads();
    }
}
DI void cmp_bias_part(const float* __restrict__ pos, const float* __restrict__ w1, float* __restrict__ partial, int w, float* ldsf) {
    const int tid = threadIdx.x, n = tid & 127, part = tid >> 7;
    float s = 0.f;
    const int kb = w * 256 + part * 64;
#pragma unroll 8
    for (int k = kb; k < kb + 64; ++k) s += pos[k] * w1[(size_t)k * 128 + n];
    ldsf[tid] = s;
    __syncthreads();
    if (tid < 128) partial[w * 128 + tid] = (ldsf[tid] + ldsf[tid + 128]) + (ldsf[tid + 256] + ldsf[tid + 384]);
    __syncthreads();
}

template <int MODE, bool BASE_BF = false, bool XO_BF = false, bool HS = false> DI void rowwise(const float* __restrict__ y, const void* base, void* xo, bf16_t* __restrict__ hout,
                                    const float* __restrict__ gp, const float* __restrict__ g1, float fac, int bid, int G) {
    const int lane = threadIdx.x & 63, wave = threadIdx.x >> 6;
    for (int row = bid * 8 + wave; row < T_; row += G * 8) {
        f32x4 v[8];
        if (MODE == 0) {
#pragma unroll
            for (int i = 0; i < 8; ++i) v[i] = __builtin_nontemporal_load((const f32x4*)(y + (size_t)row * D_ + i * 256 + lane * 4));
        } else {
            u32x2 yw[8]; f32x4 bs[8]; u32x2 bw[8];
#pragma unroll
            for (int i = 0; i < 8; ++i) yw[i] = __builtin_nontemporal_load((const u32x2*)((const bf16_t*)y + (size_t)row * D_ + i * 256 + lane * 4));
#pragma unroll
            for (int i = 0; i < 8; ++i) {
                if (BASE_BF) bw[i] = __builtin_nontemporal_load((const u32x2*)((const bf16_t*)base + (size_t)row * D_ + i * 256 + lane * 4));
                else bs[i] = __builtin_nontemporal_load((const f32x4*)((const float*)base + (size_t)row * D_ + i * 256 + lane * 4));
            }
            float ss = 0.f;
#pragma unroll
            for (int i = 0; i < 8; ++i) {
                const u32x2 w = yw[i];
                v[i] = (f32x4){__uint_as_float(w.x << 16), __uint_as_float(w.x & 0xffff0000u), __uint_as_float(w.y << 16), __uint_as_float(w.y & 0xffff0000u)};
                ss += (v[i][0] * v[i][0] + v[i][1] * v[i][1]) + (v[i][2] * v[i][2] + v[i][3] * v[i][3]); }
            ss = wave_sum(ss);
            const float r = rsqrtf(ss * (1.0f / D_) + EPS) * fac;
#pragma unroll
            for (int i = 0; i < 8; ++i) {
                if (BASE_BF) { const u32x2 w = bw[i]; bs[i] = (f32x4){__uint_as_float(w.x << 16), __uint_as_float(w.x & 0xffff0000u), __uint_as_float(w.y << 16), __uint_as_float(w.y & 0xffff0000u)}; }
                const f32x4 gg = *(const f32x4*)(gp + i * 256 + lane * 4);
                v[i] = bs[i] + v[i] * r * gg;
                if (XO_BF) { u32x2 w; w.x = pk2(v[i][0], v[i][1]); w.y = pk2(v[i][2], v[i][3]); *(u32x2*)((bf16_t*)xo + (size_t)row * D_ + i * 256 + lane * 4) = w; }
                else if (MODE == 2) __builtin_nontemporal_store(v[i], (f32x4*)((float*)xo + (size_t)row * D_ + i * 256 + lane * 4));
                else *(f32x4*)((float*)xo + (size_t)row * D_ + i * 256 + lane * 4) = v[i];
            }
        }
        if (MODE != 2) {
            float ss = 0.f;
#pragma unroll
            for (int i = 0; i < 8; ++i) ss += (v[i][0] * v[i][0] + v[i][1] * v[i][1]) + (v[i][2] * v[i][2] + v[i][3] * v[i][3]);
            ss = wave_sum(ss);
            const float r = rsqrtf(ss * (1.0f / D_) + EPS);
            if (HS) { if (lane == 0) ((float*)hout)[row] = r; }
            else {
#pragma unroll
            for (int i = 0; i < 8; ++i) {
                const f32x4 gg = *(const f32x4*)(g1 + i * 256 + lane * 4);
                const f32x4 o = v[i] * r * gg;
                u32x2 w; w.x = pk2(o[0], o[1]); w.y = pk2(o[2], o[3]);
                *(u32x2*)(hout + (size_t)row * D_ + i * 256 + lane * 4) = w;
            }
            }
        }
    }
}

using pg8::Unit; using pg8::HALF; using pg8::BM;
struct EpiNull {
    static constexpr bool PERM = true, AFTER_DRAIN = false;
    float* sink; unsigned flag;
    DI void operator()(const f32x4 (&acc)[2][2][4][2], const Unit& u, int wr, int wc, int fr, int fq) const {
        if (flag == 0x1234u) {
            f32x4 t = (f32x4){0.f, 0.f, 0.f, 0.f};
#pragma unroll
            for (int ai = 0; ai < 2; ++ai)
#pragma unroll
                for (int bj = 0; bj < 2; ++bj)
#pragma unroll
                    for (int m = 0; m < 4; ++m)
#pragma unroll
                        for (int n = 0; n < 2; ++n) t += acc[ai][bj][m][n];
            *(f32x4*)(sink + threadIdx.x * 4) = t;
        }
    }
};
template <bool RS> struct EpiSwigluT {
    static constexpr bool PERM = true, AFTER_DRAIN = false;
    bf16_t* O; const float* rs;
    DI void operator()(const f32x4 (&acc)[2][2][4][2], const Unit& u, int wr, int wc, int fr, int fq) const {
        const int row0 = u.pm * BM + wr * 64 + fr, col0 = u.pn * 128 + wc * 32 + 8 * fq;
#pragma unroll
        for (int ai = 0; ai < 2; ++ai)
#pragma unroll
            for (int m = 0; m < 4; ++m) {
                float o[8];
                const float rr = RS ? rs[row0 + ai * HALF + m * 16] : 1.0f;
#pragma unroll
                for (int n = 0; n < 2; ++n)
#pragma unroll
                    for (int j = 0; j < 4; ++j) { const float gt = acc[ai][0][m][n][j] * rr, up = acc[ai][1][m][n][j] * rr; o[n * 4 + j] = gt * __builtin_amdgcn_rcpf(1.0f + __expf(-gt)) * up; }
                u32x4 w; w.x = pk2(o[0], o[1]); w.y = pk2(o[2], o[3]); w.z = pk2(o[4], o[5]); w.w = pk2(o[6], o[7]);
                *(u32x4*)(O + (size_t)(row0 + ai * HALF + m * 16) * FF_ + col0) = w;
            }
    }
};
typedef EpiSwigluT<false> EpiSwiglu;
struct EpiInprojA {
    static constexpr bool PERM = true, AFTER_DRAIN = false;
    unsigned char* ws; const float* rs;
    DI void operator()(const f32x4 (&acc)[2][2][4][2], const Unit& u, int wr, int wc, int fr, int fq) const {
        const int pn = __builtin_amdgcn_readfirstlane(u.pn);
        const int row0 = __builtin_amdgcn_readfirstlane(u.pm) * BM + wr * 64 + fr;
        const int cl0 = wc * 32 + 8 * fq;
        if (pn == 32) {
            float* gn = (float*)(ws + WS_GN);
            if (wc == 0) {
#pragma unroll
                for (int ai = 0; ai < 2; ++ai)
#pragma unroll
                    for (int m = 0; m < 4; ++m) {
                        const int r = row0 + ai * HALF + m * 16;
#pragma unroll
                        for (int n = 0; n < 2; ++n) { f32x4 v = acc[ai][0][m][n] * rs[r]; f32x4 o; for (int j = 0; j < 4; ++j) o[j] = sigmoidf_(v[j]); *(f32x4*)(gn + (size_t)r * 32 + cl0 + 4 * n) = o; }
                    }
            }
            return;
        }
        bf16_t* base; int pitch, cbase; bool sig = false, dense = false;
        if (pn < 4) { base = (bf16_t*)(ws + WS_QSB); pitch = 1024; cbase = pn * 256; }
        else if (pn < 8) { base = (bf16_t*)(ws + WS_KSB); pitch = 1024; cbase = (pn - 4) * 256; }
        else if (pn < 12) { base = (bf16_t*)(ws + WS_QNSA); pitch = 1024; cbase = (pn - 8) * 256; }
        else if (pn == 12) { base = (bf16_t*)(ws + WS_KCK); pitch = 128; cbase = 0; dense = true; }
        else if (pn == 13) { base = (bf16_t*)(ws + WS_KCV); pitch = 128; cbase = 0; dense = true; }
        else if (pn == 14) { base = (bf16_t*)(ws + WS_KSLC); pitch = 256; cbase = 0; }
        else if (pn == 15) { base = (bf16_t*)(ws + WS_KWIN); pitch = 256; cbase = 0; }
        else { base = (bf16_t*)(ws + WS_Y); pitch = 4096; cbase = (pn - 16) * 256; sig = true; }
#pragma unroll
        for (int ai = 0; ai < 2; ++ai)
#pragma unroll
            for (int m = 0; m < 4; ++m) {
                const int r = row0 + ai * HALF + m * 16;
                const float rr = rs[r];
#pragma unroll
                for (int bj = 0; bj < 2; ++bj) {
                    f32x4 v0 = acc[ai][bj][m][0] * rr, v1 = acc[ai][bj][m][1] * rr;
                    if (sig) { for (int j = 0; j < 4; ++j) { v0[j] = sigmoidf_(v0[j]); v1[j] = sigmoidf_(v1[j]); } }
                    u32x4 w; w.x = pk2(v0[0], v0[1]); w.y = pk2(v0[2], v0[3]); w.z = pk2(v1[0], v1[1]); w.w = pk2(v1[2], v1[3]);
                    const int c = bj * HALF + cl0;
                    size_t off;
                    if (dense) { const int b = r >> 12, s = r & 4095, g = c >> 7, d = c & 127; off = ((size_t)((b * 2 + g) * S_ + s)) * 128 + d; }
                    else off = (size_t)r * pitch + cbase + c;
                    *(u32x4*)(base + off) = w;
                }
            }
    }
};
struct EpiInprojB {
    static constexpr bool PERM = true, AFTER_DRAIN = false;
    unsigned char* ws; const float* rs;
    DI void operator()(const f32x4 (&acc)[2][2][4][2], const Unit& u, int wr, int wc, int fr, int fq) const {
        const int pn = __builtin_amdgcn_readfirstlane(u.pn);
        const int row0 = __builtin_amdgcn_readfirstlane(u.pm) * BM + wr * 64 + fr;
        const int cl0 = wc * 32 + 8 * fq;
        bf16_t* vt; int ncol, cbase;
        if (pn < 4) { vt = (bf16_t*)(ws + WS_VTSB); ncol = 1024; cbase = pn * 256; }
        else if (pn == 4) { vt = (bf16_t*)(ws + WS_VTSLC); ncol = 256; cbase = 0; }
        else { vt = (bf16_t*)(ws + WS_VTWIN); ncol = 256; cbase = 0; }
#pragma unroll
        for (int ai = 0; ai < 2; ++ai)
#pragma unroll
            for (int m = 0; m < 4; ++m) {
                const int r = row0 + ai * HALF + m * 16, b = r >> 12, s = r & 4095;
                bf16_t* pp = vt + ((size_t)(b * ncol + cbase + cl0)) * S_ + s;
                const float rr = rs[r];
#pragma unroll
                for (int bj = 0; bj < 2; ++bj) {
#pragma unroll
                    for (int n = 0; n < 2; ++n)
#pragma unroll
                        for (int j = 0; j < 4; ++j) { *pp = f2bf(acc[ai][bj][m][n][j] * rr); pp += S_; asm volatile("" : "+v"(pp)); }
                    pp += (size_t)(HALF - 8) * S_; asm volatile("" : "+v"(pp));
                }
            }
    }
};
DI float gelu_tanh(float x) { const float u = 0.7978845608028654f * (x + 0.044715f * x * x * x); const float e = __expf(2.0f * u); const float th = 1.0f - 2.0f / (e + 1.0f); return 0.5f * x * (1.0f + th); }
struct EpiPart {
    static constexpr bool PERM = false, AFTER_DRAIN = false;
    float* P;
    DI void operator()(const f32x4 (&acc)[2][2][4][2], const Unit& u, int wr, int wc, int fr, int fq) const {
        const int row0 = __builtin_amdgcn_readfirstlane(u.pm) * BM + wr * 64 + fr, c0 = wc * 32 + 4 * fq;
#pragma unroll
        for (int ai = 0; ai < 2; ++ai)
#pragma unroll
            for (int m = 0; m < 4; ++m) {
                float* rowp = P + (size_t)(row0 + ai * HALF + m * 16) * 128 + c0;
#pragma unroll
                for (int n = 0; n < 2; ++n) *(f32x4*)(rowp + n * 16) = acc[ai][0][m][n];
            }
    }
};
DI void cmp_g1_tile(const float* __restrict__ part, const float* __restrict__ biasp, bf16_t* __restrict__ G1, int pm) {
    const int tid = threadIdx.x, c4 = (tid & 31) * 4, r0 = tid >> 5;
    f32x4 bv = (f32x4){0.f, 0.f, 0.f, 0.f};
    for (int w = 0; w < 16; ++w) bv += *(const f32x4*)(biasp + w * 128 + c4);
    for (int rr = r0; rr < 256; rr += 16) {
        const size_t r = (size_t)pm * 256 + rr;
        f32x4 v = bv;
#pragma unroll
        for (int q = 0; q < 4; ++q) v += __builtin_nontemporal_load((const f32x4*)(part + (size_t)q * 2048 * 128 + r * 128 + c4));
        u32x2 w; w.x = pk2(gelu_tanh(v[0]), gelu_tanh(v[1])); w.y = pk2(gelu_tanh(v[2]), gelu_tanh(v[3]));
        *(u32x2*)(G1 + r * 256 + c4) = w;
        u32x2 z; z.x = 0u; z.y = 0u;
        *(u32x2*)(G1 + r * 256 + 128 + c4) = z;
    }
}
struct EpiCmp1 {
    static constexpr bool PERM = true, AFTER_DRAIN = false;
    bf16_t* O; const float* bias;
    DI void operator()(const f32x4 (&acc)[2][2][4][2], const Unit& u, int wr, int wc, int fr, int fq) const {
        const int row0 = u.pm * BM + wr * 64 + fr, cl0 = wc * 32 + 8 * fq;
        f32x4 b0 = (f32x4){0.f, 0.f, 0.f, 0.f}, b1 = b0;
        for (int w = 0; w < 16; ++w) { b0 += *(const f32x4*)(bias + w * 128 + cl0); b1 += *(const f32x4*)(bias + w * 128 + cl0 + 4); }
#pragma unroll
        for (int ai = 0; ai < 2; ++ai)
#pragma unroll
            for (int m = 0; m < 4; ++m) {
                const int r = row0 + ai * HALF + m * 16;
                f32x4 v0 = acc[ai][0][m][0] + b0, v1 = acc[ai][0][m][1] + b1;
                for (int j = 0; j < 4; ++j) { v0[j] = gelu_tanh(v0[j]); v1[j] = gelu_tanh(v1[j]); }
                u32x4 w; w.x = pk2(v0[0], v0[1]); w.y = pk2(v0[2], v0[3]); w.z = pk2(v1[0], v1[1]); w.w = pk2(v1[2], v1[3]);
                *(u32x4*)(O + (size_t)r * 256 + cl0) = w;
                u32x4 z; z.x = 0; z.y = 0; z.z = 0; z.w = 0;
                *(u32x4*)(O + (size_t)r * 256 + 128 + cl0) = z;
            }
    }
};
template <int TRANSP> struct EpiCmp2 {
    static constexpr bool PERM = true, AFTER_DRAIN = false;
    bf16_t* O;
    DI void operator()(const f32x4 (&acc)[2][2][4][2], const Unit& u, int wr, int wc, int fr, int fq) const {
        const int row0 = u.pm * BM + wr * 64 + fr, cl0 = wc * 32 + 8 * fq;
#pragma unroll
        for (int ai = 0; ai < 2; ++ai)
#pragma unroll
            for (int m = 0; m < 4; ++m) {
                const int r = row0 + ai * HALF + m * 16;
                const f32x4 v0 = acc[ai][0][m][0], v1 = acc[ai][0][m][1];
                if (TRANSP == 0) {
                    u32x4 w; w.x = pk2(v0[0], v0[1]); w.y = pk2(v0[2], v0[3]); w.z = pk2(v1[0], v1[1]); w.w = pk2(v1[2], v1[3]);
                    *(u32x4*)(O + (size_t)r * 128 + cl0) = w;
                } else {
#pragma unroll
                    for (int j = 0; j < 4; ++j) { O[((size_t)(u.pm * 128 + cl0 + j)) * 256 + (r & 255)] = f2bf(v0[j]); O[((size_t)(u.pm * 128 + cl0 + 4 + j)) * 256 + (r & 255)] = f2bf(v1[j]); }
                }
            }
    }
};
template <int SECOND> struct EpiBranch {
    static constexpr bool PERM = true, AFTER_DRAIN = false;
    bf16_t* Hh; const bf16_t* Gm;
    DI void operator()(const f32x4 (&acc)[2][2][4][2], const Unit& u, int wr, int wc, int fr, int fq) const {
        const int row0 = u.pm * BM + wr * 64 + fr, col0 = u.pn * BM + wc * 32 + 8 * fq;
#pragma unroll
        for (int ai = 0; ai < 2; ++ai)
#pragma unroll
            for (int m = 0; m < 4; ++m) {
                const int r = row0 + ai * HALF + m * 16;
#pragma unroll
                for (int bj = 0; bj < 2; ++bj) {
                    const int c = col0 + bj * HALF;
                    const u32x4 gw = __builtin_nontemporal_load((const u32x4*)(Gm + (size_t)r * 4096 + SECOND * 2048 + c));
                    float o[8];
#pragma unroll
                    for (int n = 0; n < 2; ++n)
#pragma unroll
                        for (int j = 0; j < 4; ++j) o[n * 4 + j] = acc[ai][bj][m][n][j];
                    const unsigned gws[4] = {gw.x, gw.y, gw.z, gw.w};
#pragma unroll
                    for (int q = 0; q < 4; ++q) { o[2 * q] *= __uint_as_float(gws[q] << 16); o[2 * q + 1] *= __uint_as_float(gws[q] & 0xffff0000u); }
                    if (SECOND) {
                        const u32x4 hw = __builtin_nontemporal_load((const u32x4*)(Hh + (size_t)r * D_ + c));
                        const unsigned hws[4] = {hw.x, hw.y, hw.z, hw.w};
#pragma unroll
                        for (int q = 0; q < 4; ++q) { o[2 * q] += __uint_as_float(hws[q] << 16); o[2 * q + 1] += __uint_as_float(hws[q] & 0xffff0000u); }
                    }
                    u32x4 w; w.x = pk2(o[0], o[1]); w.y = pk2(o[2], o[3]); w.z = pk2(o[4], o[5]); w.w = pk2(o[6], o[7]);
                    *(u32x4*)(Hh + (size_t)r * D_ + c) = w;
                }
            }
    }
};

constexpr int KPITCH = 272, VPITCH = 136, KBYTES = 64 * KPITCH, VBYTES = 128 * VPITCH, TILE_BYTES = KBYTES + VBYTES;
#define MFMA32(a, b, c) __builtin_amdgcn_mfma_f32_32x32x16_bf16((a), (b), (c), 0, 0, 0)
struct KVRegs { u32x4 k[2]; u32x4 v[2]; };
template <bool WITHV = true> DI void kv_load(KVRegs& R, const bf16_t* Kp, unsigned kpitch, const bf16_t* Vp, unsigned vpitch, int tid) {
    asm volatile("" : "+v"(tid));
#pragma unroll
    for (int i = 0; i < 2; ++i) { const unsigned c = tid + 512 * i; const unsigned off = (c >> 4) * kpitch + (c & 15) * 8; R.k[i] = *(const u32x4*)(Kp + off); }
    if (WITHV) {
#pragma unroll
    for (int i = 0; i < 2; ++i) { const unsigned c = tid + 512 * i; const unsigned off = (c >> 3) * vpitch + (c & 7) * 8; R.v[i] = *(const u32x4*)(Vp + off); }
    }
}
template <bool WITHV = true> DI void kv_store(const KVRegs& R, unsigned char* buf, int tid) {
    asm volatile("" : "+v"(tid));
#pragma unroll
    for (int i = 0; i < 2; ++i) { const int c = tid + 512 * i; *(u32x4*)(buf + (c >> 4) * KPITCH + (c & 15) * 16) = R.k[i]; }
    if (WITHV) {
#pragma unroll
    for (int i = 0; i < 2; ++i) { const int c = tid + 512 * i; unsigned char* p = buf + KBYTES + (c >> 3) * VPITCH + (c & 7) * 16;
        u32x2 a; a.x = R.v[i].x; a.y = R.v[i].y; u32x2 b; b.x = R.v[i].z; b.y = R.v[i].w; *(u32x2*)p = a; *(u32x2*)(p + 8) = b; }
    }
}
DI void qk_tile(const unsigned char* kt, const bf16x8 (&qf)[8], f32x16 (&s)[2], int lane) {
    const int key = lane & 31, h = lane >> 5;
    const unsigned char* base = kt + key * KPITCH + h * 16;
#pragma unroll
    for (int kb = 0; kb < 2; ++kb) {
#pragma unroll
        for (int i = 0; i < 16; ++i) s[kb][i] = 0.f;
#pragma unroll
        for (int kg = 0; kg < 2; ++kg) {
            bf16x8 a[4];
#pragma unroll
            for (int q = 0; q < 4; ++q) a[q] = *(const bf16x8*)(base + kb * 32 * KPITCH + (kg * 4 + q) * 32);
#pragma unroll
            for (int q = 0; q < 4; ++q) s[kb] = MFMA32(a[q], qf[kg * 4 + q], s[kb]);
            __builtin_amdgcn_sched_barrier(0);
        }
    }
}
DI void pv_tile(const unsigned char* vt, const bf16x8 (&pf)[4], f32x16 (&o)[4], int lane) {
    const int dl = lane & 31, h = lane >> 5;
    const unsigned char* base = vt + dl * VPITCH + 8 * h;
#pragma unroll
    for (int db = 0; db < 4; ++db) {
        bf16x8 a[4];
#pragma unroll
        for (int kk = 0; kk < 4; ++kk) {
            const unsigned char* p = base + db * 32 * VPITCH + kk * 32;
            const s16x4 lo = *(const s16x4*)p, hi = *(const s16x4*)(p + 16);
            a[kk] = __builtin_shufflevector(lo, hi, 0, 1, 2, 3, 4, 5, 6, 7);
        }
#pragma unroll
        for (int kk = 0; kk < 4; ++kk) o[db] = MFMA32(a[kk], pf[kk], o[db]);
        __builtin_amdgcn_sched_barrier(0);
    }
}
DI void qk_half(const unsigned char* kt, int kb, const bf16x8 (&qf)[8], f32x16& s1, int lane) {
    const int key = lane & 31, h = lane >> 5;
    const unsigned char* base = kt + (kb * 32 + key) * KPITCH + h * 16;
#pragma unroll
    for (int i = 0; i < 16; ++i) s1[i] = 0.f;
#pragma unroll
    for (int kg = 0; kg < 2; ++kg) {
        bf16x8 a[4];
#pragma unroll
        for (int q = 0; q < 4; ++q) a[q] = *(const bf16x8*)(base + (kg * 4 + q) * 32);
#pragma unroll
        for (int q = 0; q < 4; ++q) s1 = MFMA32(a[q], qf[kg * 4 + q], s1);
    }
}
DI void pv_half(const unsigned char* vt, int kb, const bf16x8 (&pf)[2], f32x16 (&o)[4], int lane) {
    const int dl = lane & 31, h = lane >> 5;
    const unsigned char* base = vt + dl * VPITCH + 8 * h + kb * 64;
#pragma unroll
    for (int dp = 0; dp < 2; ++dp) {
        bf16x8 a[4];
#pragma unroll
        for (int q = 0; q < 4; ++q) {
            const unsigned char* p = base + (dp * 2 + (q >> 1)) * 32 * VPITCH + (q & 1) * 32;
            const s16x4 lo = *(const s16x4*)p, hi = *(const s16x4*)(p + 16);
            a[q] = __builtin_shufflevector(lo, hi, 0, 1, 2, 3, 4, 5, 6, 7);
        }
#pragma unroll
        for (int q = 0; q < 4; ++q) o[dp * 2 + (q >> 1)] = MFMA32(a[q], pf[q & 1], o[dp * 2 + (q >> 1)]);
    }
}
DI void pack_half(const f32x16& s1, bf16x8 (&pf)[2]) {
#pragma unroll
    for (int ss = 0; ss < 2; ++ss) {
        u32x4 w; w.x = pk2(s1[8 * ss + 0], s1[8 * ss + 1]); w.y = pk2(s1[8 * ss + 2], s1[8 * ss + 3]); w.z = pk2(s1[8 * ss + 4], s1[8 * ss + 5]); w.w = pk2(s1[8 * ss + 6], s1[8 * ss + 7]);
        pf[ss] = __builtin_bit_cast(bf16x8, w);
    }
}
DI void pack_p(const f32x16 (&s)[2], bf16x8 (&pf)[4]) {
#pragma unroll
    for (int kb = 0; kb < 2; ++kb)
#pragma unroll
        for (int ss = 0; ss < 2; ++ss) {
            u32x4 w; w.x = pk2(s[kb][8 * ss + 0], s[kb][8 * ss + 1]); w.y = pk2(s[kb][8 * ss + 2], s[kb][8 * ss + 3]); w.z = pk2(s[kb][8 * ss + 4], s[kb][8 * ss + 5]); w.w = pk2(s[kb][8 * ss + 6], s[kb][8 * ss + 7]);
            pf[kb * 2 + ss] = __builtin_bit_cast(bf16x8, w);
        }
}
DI void store_o(bf16_t* orow, const f32x16 (&o)[4], int lane) {
    const int h = lane >> 5;
#pragma unroll
    for (int db = 0; db < 4; ++db)
#pragma unroll
        for (int g4 = 0; g4 < 4; ++g4) {
            u32x2 w; w.x = pk2(o[db][4 * g4 + 0], o[db][4 * g4 + 1]); w.y = pk2(o[db][4 * g4 + 2], o[db][4 * g4 + 3]);
            *(u32x2*)(orow + db * 32 + g4 * 8 + 4 * h) = w;
        }
}

DI void sb_item(unsigned char* ws, unsigned char* lds, int b, int hh, int qblk, bf16_t* outb) {
    const int tid = threadIdx.x, lane = tid & 63, wave = __builtin_amdgcn_readfirstlane(tid >> 6), col = lane & 31, h = lane >> 5;
    const int t = qblk * 256 + wave * 32 + col;
    const bf16_t* qrow = (const bf16_t*)(ws + WS_QSB) + ((size_t)(b * S_ + t)) * 1024 + hh * 128;
    bf16x8 qf[8];
#pragma unroll
    for (int ks = 0; ks < 8; ++ks) qf[ks] = __builtin_nontemporal_load((const bf16x8*)(qrow + ks * 16 + h * 8));
    f32x16 o[4];
#pragma unroll
    for (int db = 0; db < 4; ++db)
#pragma unroll
        for (int i = 0; i < 16; ++i) o[db][i] = 0.f;
    float R = 0.f;
    const bf16_t* Kb = (const bf16_t*)(ws + WS_KSB) + ((size_t)b * S_) * 1024 + hh * 128;
    const bf16_t* Vb = (const bf16_t*)(ws + WS_VTSB) + ((size_t)(b * 8 + hh) * 128) * S_;
    const int nt = qblk * 4 + 4;
    const int wmax = (qblk * 256 + wave * 32 + 30) >> 6;
    KVRegs Rg;
    kv_load(Rg, Kb + (size_t)((nt - 1) * 64) * 1024, 1024, Vb + (nt - 1) * 64, S_, tid);
    kv_store(Rg, lds, tid);
    __syncthreads();
    for (int it = 0; it < nt; ++it) {
        const int kt = nt - 1 - it, cur = it & 1;
        if (it + 1 < nt) kv_load(Rg, Kb + (size_t)((kt - 1) * 64) * 1024, 1024, Vb + (kt - 1) * 64, S_, tid);
        if (kt <= wmax) {
            const unsigned char* buf = lds + cur * TILE_BYTES;
            f32x16 s[2], lm[2];
            qk_tile(buf, qf, s, lane);
            const int key0 = kt * 64;
#pragma unroll
            for (int kb = 0; kb < 2; ++kb)
#pragma unroll
                for (int i = 0; i < 16; ++i) {
                    const int kpos = key0 + 32 * kb + 8 * (i >> 2) + 4 * h + (i & 3);
                    const float z = s[kb][i] * QSCALE;
                    const float sp = __logf(1.0f + __expf(-fabsf(z)));
                    const bool valid = kpos < t;
                    s[kb][i] = valid ? z : 0.f;
                    lm[kb][i] = valid ? -(fmaxf(z, 0.f) + sp) : 0.f;
                }
            float own[8], par[8], sufg[8];
#pragma unroll
            for (int m = 0; m < 8; ++m) { const int kb = m >> 2, g4 = m & 3; own[m] = (lm[kb][4 * g4] + lm[kb][4 * g4 + 1]) + (lm[kb][4 * g4 + 2] + lm[kb][4 * g4 + 3]); }
#pragma unroll
            for (int m = 0; m < 8; ++m) par[m] = __shfl_xor(own[m], 32);
            float Tt = 0.f;
#pragma unroll
            for (int m = 7; m >= 0; --m) { sufg[m] = Tt + (h == 0 ? par[m] : 0.f); Tt += own[m] + par[m]; }
#pragma unroll
            for (int kb = 0; kb < 2; ++kb)
#pragma unroll
                for (int g4 = 0; g4 < 4; ++g4) {
                    float run = R + sufg[kb * 4 + g4];
#pragma unroll
                    for (int i = 3; i >= 0; --i) {
                        const int idx = 4 * g4 + i;
                        const int kpos = key0 + 32 * kb + 8 * g4 + 4 * h + i;
                        const float l1 = lm[kb][idx];
                        const float lb = l1 + s[kb][idx];
                        const float w = (kpos < t) ? __expf(lb + run) : 0.f;
                        run += l1;
                        s[kb][idx] = w;
                    }
                }
            R += Tt;
            bf16x8 pf[4];
            pack_p(s, pf);
            pv_tile(buf + KBYTES, pf, o, lane);
        }
        if (it + 1 < nt) kv_store(Rg, lds + (cur ^ 1) * TILE_BYTES, tid);
        const int wdone = (kt <= wmax) && __all(R < -104.0f);
        if (__syncthreads_and(wdone)) break;
    }
    store_o(outb + ((size_t)(b * S_ + t)) * 1024 + hh * 128, o, lane);
}

constexpr int SC_PITCH = 65;
constexpr int NSA_SCA = 2 * TILE_BYTES, NSA_SCB = NSA_SCA + 64 * SC_PITCH * 4, NSA_UNI = NSA_SCB + 64 * SC_PITCH * 4, NSA_SEL = NSA_UNI + 16, NSA_STASH = NSA_SEL + 64 * 8, NSA_END = NSA_STASH + 512 * 8;
static_assert(NSA_END <= LDS_BYTES, "LDS");
template <int MK, int OP, bool PRE, int NXT> DI void nsa_branch(unsigned long long tiles, const bf16_t* Kp, unsigned kpitch, const bf16_t* Vp, unsigned vpitch, unsigned char* lds,
                                       const bf16x8 (&qf)[8], int t, int qb, float slope2, float& m, float& l, f32x16 (&o)[4], float pscale, unsigned mlo, unsigned mhi, int qloc, int r,
                                       int& cur, const bf16_t* nxtK, unsigned nxtkp, const bf16_t* nxtV, unsigned nxtvp, int nxt_tile) {
    const int tid = threadIdx.x, lane = tid & 63, h = lane >> 5;
    const float sc2 = QSCALE * LOG2E;
    unsigned tlo = __builtin_amdgcn_readfirstlane((unsigned)tiles), thi = __builtin_amdgcn_readfirstlane((unsigned)(tiles >> 32));
    unsigned long long tl = ((unsigned long long)thi << 32) | tlo;
    int j;
    if (MK == 0) { j = __builtin_ctzll(tl); tl &= tl - 1; } else { j = 63 - __builtin_clzll(tl); tl &= ~(1ull << j); }
    KVRegs Rg;
    if (!PRE) {
        kv_load<(OP >= 2)>(Rg, Kp + (size_t)(j * 64) * kpitch, kpitch, Vp + j * 64, vpitch, tid);
        kv_store<(OP >= 2)>(Rg, lds + cur * TILE_BYTES, tid);
        __syncthreads();
    }
    for (;;) {
        int jn = -1;
        if (tl != 0ull) {
            if (MK == 0) { jn = __builtin_ctzll(tl); tl &= tl - 1; } else { jn = 63 - __builtin_clzll(tl); tl &= ~(1ull << jn); }
            kv_load<(OP >= 2)>(Rg, Kp + (size_t)(jn * 64) * kpitch, kpitch, Vp + jn * 64, vpitch, tid);
        } else if (NXT != 0) {
            kv_load<(NXT == 2)>(Rg, nxtK + (size_t)(nxt_tile * 64) * nxtkp, nxtkp, nxtV + nxt_tile * 64, nxtvp, tid);
        }
        const unsigned char* buf = lds + cur * TILE_BYTES;
        const int key0 = j * 64;
        const bool selbit = (MK == 1) ? (((j < 32 ? (mlo >> j) : (mhi >> (j - 32))) & 1u) != 0u) : true;
        const bool bnd = (MK == 0) ? true : ((MK == 1) ? (j == qb) : (j == qb || j == qb - 8));
        int dbase = (MK == 0) ? (t - 31 - 16 * (key0 + 4 * h)) : (t - key0 - 4 * h);
        asm volatile("" : "+v"(dbase));
        const float fbase = (float)dbase;
        float B0 = -slope2 * fbase;
        if (MK == 1 && !selbit) B0 = -1e30f;
        const bool wave_skip = (MK == 1) && !bnd && !__any(selbit);
        if (!wave_skip)
#pragma unroll
        for (int kb = 0; kb < 2; ++kb) {
            f32x16 s1;
            qk_half(buf, kb, qf, s1, lane);
            float tm = -1e30f;
            if (bnd) {
#pragma unroll
                for (int i = 0; i < 16; ++i) {
                    const int e = 32 * kb + 8 * (i >> 2) + (i & 3);
                    const int dstep = (MK == 0) ? 16 : 1;
                    const int dist = dbase - dstep * e;
                    bool valid;
                    if (MK == 2) valid = (dist >= 0) && (dist < 512); else valid = dist >= 0;
                    const float v = valid ? __builtin_fmaf(s1[i], sc2, __builtin_fmaf(slope2, (float)(dstep * e), B0)) : -1e30f;
                    s1[i] = v;
                    tm = fmaxf(tm, v);
                }
            } else {
#pragma unroll
                for (int i = 0; i < 16; ++i) {
                    const int e = 32 * kb + 8 * (i >> 2) + (i & 3);
                    const float v = __builtin_fmaf(s1[i], sc2, __builtin_fmaf(slope2, (float)e, B0));
                    s1[i] = v;
                    tm = fmaxf(tm, v);
                }
            }
            if (OP == 1) {
                float A[4], Bv[4];
#pragma unroll
                for (int i = 0; i < 16; ++i) { const float v = s1[i]; s1[i] = (v > -1e29f) ? __builtin_amdgcn_exp2f(v - m) * l : 0.f; }
#pragma unroll
                for (int g4 = 0; g4 < 4; ++g4) { A[g4] = s1[4 * g4] + 2.0f * ((s1[4 * g4 + 1] + s1[4 * g4 + 2]) + s1[4 * g4 + 3]); Bv[g4] = s1[4 * g4]; }
#pragma unroll
                for (int g4 = 0; g4 < 4; ++g4) { A[g4] += __shfl_xor(A[g4], 8); A[g4] += __shfl_xor(A[g4], 16); Bv[g4] += __shfl_xor(Bv[g4], 8); Bv[g4] += __shfl_xor(Bv[g4], 16); }
                float* scA = (float*)(lds + NSA_SCA); float* scB = (float*)(lds + NSA_SCB);
#pragma unroll
                for (int g4 = 0; g4 < 4; ++g4) {
                    const int jj = j * 16 + kb * 8 + 2 * g4 + h;
                    if (r == 0) scA[qloc * SC_PITCH + jj] = A[g4];
                    if (r == 1 && jj >= 1) scB[qloc * SC_PITCH + jj - 1] = Bv[g4];
                }
            } else if (OP == 3) {
                if (MK == 0) {
#pragma unroll
                    for (int i = 0; i < 16; ++i) { const float v = s1[i]; s1[i] = (v > -1e29f) ? __builtin_amdgcn_exp2f(v - m) * pscale : 0.f; }
                } else {
#pragma unroll
                    for (int i = 0; i < 16; ++i) s1[i] = __builtin_amdgcn_exp2f(s1[i] - m) * pscale;
                }
                bf16x8 pf[2];
                pack_half(s1, pf);
                pv_half(buf + KBYTES, kb, pf, o, lane);
            } else {
                tm = fmaxf(tm, __shfl_xor(tm, 32));
                const float mn = fmaxf(m, tm);
                const float alpha = __builtin_amdgcn_exp2f(m - mn);
                float ps = 0.f;
                if (MK == 0) {
#pragma unroll
                    for (int i = 0; i < 16; ++i) { const float v = s1[i]; const float p = (v > -1e29f) ? __builtin_amdgcn_exp2f(v - mn) : 0.f; s1[i] = p; ps += p; }
                } else {
#pragma unroll
                    for (int i = 0; i < 16; ++i) { const float p = __builtin_amdgcn_exp2f(s1[i] - mn); s1[i] = p; ps += p; }
                }
                l = l * alpha + ps;
                m = mn;
                if (OP == 2) {
                    if (!__all(alpha == 1.0f)) {
#pragma unroll
                        for (int db = 0; db < 4; ++db)
#pragma unroll
                            for (int i = 0; i < 16; ++i) o[db][i] *= alpha;
                    }
                    bf16x8 pf[2];
                    pack_half(s1, pf);
                    pv_half(buf + KBYTES, kb, pf, o, lane);
                }
            }
        }
        if (jn >= 0) kv_store<(OP >= 2)>(Rg, lds + (cur ^ 1) * TILE_BYTES, tid);
        else if (NXT != 0) kv_store<(NXT == 2)>(Rg, lds + (cur ^ 1) * TILE_BYTES, tid);
        __syncthreads();
        if (jn < 0) break;
        j = jn; cur ^= 1;
    }
    if (NXT != 0) cur ^= 1;
}

DI void nsa_item(unsigned char* ws, unsigned char* lds, int b, int g, int qb, bf16_t* outb) {
    const int tid = threadIdx.x, lane = tid & 63, wave = __builtin_amdgcn_readfirstlane(tid >> 6), col = lane & 31, h = lane >> 5;
    const int r = col >> 3, qi = col & 7, qloc = wave * 8 + qi;
    const int t = qb * 64 + qloc, head = g * 4 + r;
    const float slope2 = exp2f(-(float)(head + 1)) * LOG2E;
    const bf16_t* qrow = (const bf16_t*)(ws + WS_QNSA) + ((size_t)(b * S_ + t)) * 1024 + head * 128;
    bf16x8 qf[8];
#pragma unroll
    for (int ks = 0; ks < 8; ++ks) qf[ks] = __builtin_nontemporal_load((const bf16x8*)(qrow + ks * 16 + h * 8));
    float* stash = (float*)(lds + NSA_STASH) + tid * 2;
    float* scA = (float*)(lds + NSA_SCA); float* scB = (float*)(lds + NSA_SCB);
    unsigned* selm = (unsigned*)(lds + NSA_SEL); unsigned* uni = (unsigned*)(lds + NSA_UNI);
    for (int i = tid; i < 2 * 64 * SC_PITCH + 4; i += NTHREADS) scA[i] = 0.f;
    __syncthreads();
    f32x16 o[4];
#pragma unroll
    for (int db = 0; db < 4; ++db)
#pragma unroll
        for (int i = 0; i < 16; ++i) o[db][i] = 0.f;
#define NSA_KS ((const bf16_t*)(ws + WS_KSLC) + ((size_t)b * S_) * 256 + g * 128)
#define NSA_VS ((const bf16_t*)(ws + WS_VTSLC) + ((size_t)(b * 2 + g) * 128) * S_)
#define NSA_KW ((const bf16_t*)(ws + WS_KWIN) + ((size_t)b * S_) * 256 + g * 128)
#define NSA_VW ((const bf16_t*)(ws + WS_VTWIN) + ((size_t)(b * 2 + g) * 128) * S_)
#define NSA_KC ((const bf16_t*)(ws + WS_KC) + ((size_t)(b * 2 + g) * 256) * 128)
#define NSA_VC ((const bf16_t*)(ws + WS_VCT) + ((size_t)(b * 2 + g) * 128) * 256)
    int cur = 0;
    const int ntc = ((4 * qb + 2) >> 6) + 1;
    const unsigned long long ctiles = (1ull << ntc) - 1ull;
    {
        float m_c = -1e30f, inv_c = 0.f;
        float l = 0.f;
        nsa_branch<0, 0, false, 1>(ctiles, NSA_KC, 128, NSA_VC, 256, lds, qf, t, qb, slope2, m_c, l, o, 0.f, 0u, 0u, qloc, r, cur, NSA_KC, 128, NSA_VC, 256, 0);
        l += __shfl_xor(l, 32);
        inv_c = (l > 0.f) ? 1.0f / l : 0.f;
        nsa_branch<0, 1, true, 2>(ctiles, NSA_KC, 128, NSA_VC, 256, lds, qf, t, qb, slope2, m_c, inv_c, o, 0.f, 0u, 0u, qloc, r, cur, NSA_KS, 256, NSA_VS, S_, qb);
        stash[0] = m_c; stash[1] = inv_c;
    }
    {
        const int qq = tid >> 3, sub = tid & 7;
        float cand[8];
#pragma unroll
        for (int k = 0; k < 8; ++k) {
            const int jj = sub * 8 + k;
            float v = scA[qq * SC_PITCH + jj] + scB[qq * SC_PITCH + jj];
            if (jj == 0 || jj == qb || jj == qb - 1) v = 1e9f;
            if (jj > qb) v = -1e30f;
            cand[k] = v;
        }
        __syncthreads();
#pragma unroll
        for (int k = 0; k < 8; ++k) scA[qq * SC_PITCH + sub * 8 + k] = cand[k];
        __syncthreads();
        int cnt[8];
#pragma unroll
        for (int k = 0; k < 8; ++k) cnt[k] = 0;
        for (int jp = 0; jp < 64; ++jp) {
            const float v = scA[qq * SC_PITCH + jp];
#pragma unroll
            for (int k = 0; k < 8; ++k) { const int jj = sub * 8 + k; cnt[k] += ((v > cand[k]) || (v == cand[k] && jp < jj)) ? 1 : 0; }
        }
        unsigned bits = 0u;
#pragma unroll
        for (int k = 0; k < 8; ++k) if (cnt[k] < 16 && (sub * 8 + k) <= qb) bits |= (1u << k);
        unsigned lo = (sub < 4) ? (bits << (8 * sub)) : 0u, hi = (sub >= 4) ? (bits << (8 * (sub - 4))) : 0u;
        lo |= __shfl_xor(lo, 1); lo |= __shfl_xor(lo, 2); lo |= __shfl_xor(lo, 4);
        hi |= __shfl_xor(hi, 1); hi |= __shfl_xor(hi, 2); hi |= __shfl_xor(hi, 4);
        if (sub == 0) { selm[qq * 2] = lo; selm[qq * 2 + 1] = hi; atomicOr(&uni[0], lo); atomicOr(&uni[1], hi); }
        __syncthreads();
    }
    {
        const unsigned mlo = selm[qloc * 2], mhi = selm[qloc * 2 + 1];
        const unsigned long long un = ((unsigned long long)uni[1] << 32) | uni[0];
        float m = -1e30f, l = 0.f;
        nsa_branch<1, 2, true, 2>(un, NSA_KS, 256, NSA_VS, S_, lds, qf, t, qb, slope2, m, l, o, 0.f, mlo, mhi, qloc, r, cur, NSA_KC, 128, NSA_VC, 256, 0);
        l += __shfl_xor(l, 32);
        const float g_s = ((const float*)(ws + WS_GN))[(b * S_ + t) * 32 + 8 + g * 4 + ((lane & 31) >> 3)]; const float f = (l > 0.f) ? g_s / l : 0.f;
#pragma unroll
        for (int db = 0; db < 4; ++db)
#pragma unroll
            for (int i = 0; i < 16; ++i) o[db][i] *= f;
    }
    {
        float mm = stash[0], ll = 0.f;
        const float g_c = ((const float*)(ws + WS_GN))[(b * S_ + t) * 32 + g * 4 + ((lane & 31) >> 3)];
        nsa_branch<0, 3, true, 1>(ctiles, NSA_KC, 128, NSA_VC, 256, lds, qf, t, qb, slope2, mm, ll, o, stash[1] * g_c, 0u, 0u, qloc, r, cur, NSA_KW, 256, NSA_VW, S_, qb);
    }
    {
        const int lo_t = qb >= 8 ? qb - 8 : 0;
        const unsigned long long tiles = ((qb == 63) ? ~0ull : ((1ull << (qb + 1)) - 1ull)) & ~((1ull << lo_t) - 1ull);
        float m = -1e30f, l = 0.f;
        nsa_branch<2, 0, true, 2>(tiles, NSA_KW, 256, NSA_VW, S_, lds, qf, t, qb, slope2, m, l, o, 0.f, 0u, 0u, qloc, r, cur, NSA_KW, 256, NSA_VW, S_, qb);
        l += __shfl_xor(l, 32);
        const float g_w = ((const float*)(ws + WS_GN))[(b * S_ + t) * 32 + 16 + g * 4 + ((lane & 31) >> 3)]; const float f = (l > 0.f) ? g_w / l : 0.f;
        nsa_branch<2, 3, true, 0>(tiles, NSA_KW, 256, NSA_VW, S_, lds, qf, t, qb, slope2, m, l, o, f, 0u, 0u, qloc, r, cur, NSA_KW, 256, NSA_VW, S_, qb);
    }
    {
        int tid2 = threadIdx.x; asm volatile("" : "+v"(tid2));
        const int col2 = tid2 & 31, t2 = qb * 64 + (tid2 >> 6) * 8 + (col2 & 7), head2 = g * 4 + (col2 >> 3);
        store_o(outb + ((size_t)(b * S_ + t2)) * 1024 + head2 * 128, o, tid2 & 63);
    }
}
}

using mk::Params;
__global__ void __launch_bounds__(512, 2) mega_fwd(Params p) {
    extern __shared__ __attribute__((aligned(16))) unsigned char lds[];
    cg::grid_group grid = cg::this_grid();
    using namespace mk;
    const int G = gridDim.x, bid = blockIdx.x;
    PG8_LAS unsigned char* l3 = (PG8_LAS unsigned char*)lds;
    unsigned char* ws = p.ws;
#define IN(k) ((p.phmask >> (k)) & 1u)
#ifndef SKIPMASK
#define SKIPMASK 0
#endif
#define SKIP(k) ((SKIPMASK >> (k)) & 1)
#define SEAM(k) do { } while (0)
    if (threadIdx.x < 4) ((unsigned*)(lds + 131072))[threadIdx.x] = 0u;
    __syncthreads();
    XcdBarrier xbar = xcd_barrier_post((unsigned*)(ws + WS_BAR), (volatile XB_LAS unsigned*)(lds + 131072));
    if (p.pad == 0x5eedu) grid.sync();
    bf16_t* const Hb = (bf16_t*)(ws + WS_H);
    float* const Yb = (float*)(ws + WS_Y);
    bf16_t* const ACT = (bf16_t*)(ws + WS_ACT);

    if (IN(0) && !SKIP(0)) {
        convert_w<1>(p.f1_w_in, D_, 2 * FF_, (bf16_t*)(ws + WS_WFIN), D_, 2 * FF_, (unsigned*)lds, bid, G);
        convert_w<0>(p.f1_w_out, FF_, D_, (bf16_t*)(ws + WS_WFOUT), FF_, D_, (unsigned*)lds, bid, G);
        convert_w<2>(p.w_in, D_, 9752, (bf16_t*)(ws + WS_WIN), D_, NVIN, (unsigned*)lds, bid, G, p.mix_pre_g);
        convert_w<0>(p.cmp_k_w1, 4096, 128, (bf16_t*)(ws + WS_WC1K), 4096, 256, (unsigned*)lds, bid, G);
        convert_w<0>(p.cmp_v_w1, 4096, 128, (bf16_t*)(ws + WS_WC1V), 4096, 256, (unsigned*)lds, bid, G);
        convert_w<0>(p.cmp_k_w2, 128, 128, (bf16_t*)(ws + WS_WC2K), 256, 256, (unsigned*)lds, bid, G);
        convert_w<0>(p.cmp_v_w2, 128, 128, (bf16_t*)(ws + WS_WC2V), 256, 256, (unsigned*)lds, bid, G);
        if (bid >= G - 16) cmp_bias_part(p.cmp_pos_k, p.cmp_k_w1, (float*)(ws + WS_BIAS), G - 1 - bid, (float*)lds);
        else if (bid >= G - 32) cmp_bias_part(p.cmp_pos_v, p.cmp_v_w1, (float*)(ws + WS_BIAS) + 2048, G - 17 - bid, (float*)lds);
        rowwise<0>(p.x, nullptr, nullptr, Hb, nullptr, p.f1_pre_g, 1.0f, bid, G);
    }
    xcd_barrier(xbar);
    if (IN(1) && !SKIP(1)) {
        pg8::Gemm g{Hb, (const bf16_t*)(ws + WS_WFIN), T_, 2 * FF_, D_, D_}; pg8::StaticOrder S; S.init(T_, 2 * FF_, G, bid);
        EpiSwiglu E{ACT, nullptr};
        pg8::gemm_phase<EpiSwiglu, pg8::StaticOrder, true, true>(l3, g, S, E);
    }
    xcd_barrier(xbar);
    if (IN(2) && !SKIP(2)) {
        pg8::Gemm g{ACT, (const bf16_t*)(ws + WS_WFOUT), T_, D_, FF_, FF_}; pg8::StaticOrder S; S.init(T_, D_, G, bid);
        pg8::EpiBf16<0> E{(bf16_t*)Yb, D_, nullptr, 0, 0};
        pg8::gemm_phase<pg8::EpiBf16<0>, pg8::StaticOrder, true, true>(l3, g, S, E);
    }
    xcd_barrier(xbar);
    if (IN(3) && !SKIP(3)) {
        rowwise<1, false, true, true>(Yb, p.x, p.out, (bf16_t*)(ws + WS_RS2), p.f1_post_g, p.mix_pre_g, 0.5f, bid, G);
        convert_w<1>(p.f2_w_in, D_, 2 * FF_, (bf16_t*)(ws + WS_WFIN), D_, 2 * FF_, (unsigned*)lds, bid, G, p.f2_pre_g, 1088, -1);
    }
    xcd_barrier(xbar);
    if (IN(4) && !SKIP(4)) {
        {
            pg8::Gemm g{(const bf16_t*)p.out, (const bf16_t*)(ws + WS_WIN), T_, 8448, D_, D_}; pg8::StaticOrder S; S.init(T_, 8448, G, bid);
            EpiInprojA E{ws, (const float*)(ws + WS_RS2)};
            pg8::gemm_phase<EpiInprojA, pg8::StaticOrder, true, true>(l3, g, S, E);
        }
        {
            pg8::Gemm g{(const bf16_t*)p.out, (const bf16_t*)(ws + WS_WIN) + (size_t)8448 * D_, T_, 1536, D_, D_}; pg8::StaticOrder S; S.init(T_, 1536, G, (bid + G - 64) % G);
            EpiInprojB E{ws, (const float*)(ws + WS_RS2)};
            pg8::gemm_phase<EpiInprojB, pg8::StaticOrder, true, true>(l3, g, S, E);
        }
        if (bid >= G - 64) convert_w<1>(p.f2_w_in, D_, 2 * FF_, (bf16_t*)(ws + WS_WFIN), D_, 2 * FF_, (unsigned*)lds, bid - (G - 64), 64, p.f2_pre_g, 0, 1088);
    }
    xcd_barrier(xbar);
    if (IN(5) && !SKIP(5)) {
#pragma unroll 1
        for (int ci = 0; ci < 8; ++ci) {
            const bf16_t* Ab = (const bf16_t*)(ws + ((ci >> 2) ? WS_KCV : WS_KCK)) + (ci & 3) * 1024;
            const bf16_t* Bb = (const bf16_t*)(ws + ((ci >> 2) ? WS_WC1V : WS_WC1K)) + (ci & 3) * 1024;
            if (bid >= 8 * ci && bid < 8 * ci + 8) {
                pg8::Gemm g{Ab, Bb, 2048, 256, 1024, 2048}; pg8::StaticOrder S; S.init(2048, 256, G, bid - 8 * ci);
                g.ldb = 4096;
                EpiPart E{(float*)(ws + WS_CPART) + (size_t)ci * 2048 * 128};
                pg8::gemm_phase<EpiPart, pg8::StaticOrder, true, true>(l3, g, S, E);
            }
        }
        __syncthreads();
        if (G == 256) {
            const int jj = bid - 64;
            for (int k = 0; k < 3; ++k) {
                int idx = -1;
                if (bid < 64) { if (k == 0) idx = bid; }
                else if (k == 0) idx = bid; else if (k == 1) idx = bid + 192; else if (jj < 64) idx = bid + 384;
                if (idx < 0) continue;
                const int qblk = 15 - (idx >> 5), bh = idx & 31;
                sb_item(ws, lds, bh >> 3, bh & 7, qblk, (bf16_t*)(ws + WS_QSB));
            }
            if (bid >= 128) {
                convert_w<0>(p.w_branch_sb, 1024, D_, (bf16_t*)(ws + WS_WSB), 1024, D_, (unsigned*)lds, bid - 128, 128);
                convert_w<0>(p.w_branch_nsa, 1024, D_, (bf16_t*)(ws + WS_WNSA), 1024, D_, (unsigned*)lds, bid - 128, 128);
                convert_w<0>(p.w_out, D_, D_, (bf16_t*)(ws + WS_WOUT), D_, D_, (unsigned*)lds, bid - 128, 128);
            }
        } else {
            for (int k = 0;; ++k) {
                const int idx = (k & 1) ? (k + 1) * G - 1 - bid : k * G + bid;
                if (k * G >= 512) break;
                if (idx >= 512 || idx < 0) continue;
                const int qblk = 15 - (idx >> 5), bh = idx & 31;
                sb_item(ws, lds, bh >> 3, bh & 7, qblk, (bf16_t*)(ws + WS_QSB));
            }
            convert_w<0>(p.w_branch_sb, 1024, D_, (bf16_t*)(ws + WS_WSB), 1024, D_, (unsigned*)lds, bid, G);
            convert_w<0>(p.w_branch_nsa, 1024, D_, (bf16_t*)(ws + WS_WNSA), 1024, D_, (unsigned*)lds, bid, G);
            convert_w<0>(p.w_out, D_, D_, (bf16_t*)(ws + WS_WOUT), D_, D_, (unsigned*)lds, bid, G);
        }
    }
    xcd_barrier(xbar);
    if (IN(6) && !SKIP(6)) {
        if (bid < 8) {
            pg8::StaticOrder S; S.init(2048, 256, G, bid);
            cmp_g1_tile((const float*)(ws + WS_CPART), (const float*)(ws + WS_BIAS), (bf16_t*)(ws + WS_G1K), bid);
            asm volatile("s_waitcnt vmcnt(0)" ::: "memory"); __syncthreads();
            pg8::Gemm g{(const bf16_t*)(ws + WS_G1K), (const bf16_t*)(ws + WS_WC2K), 2048, 256, 256, 256}; g.ldb = 256;
            EpiCmp2<0> E{(bf16_t*)(ws + WS_KC)};
            pg8::gemm_phase<EpiCmp2<0>, pg8::StaticOrder, true, true>(l3, g, S, E);
        } else if (bid < 16) {
            pg8::StaticOrder S; S.init(2048, 256, G, bid - 8);
            cmp_g1_tile((const float*)(ws + WS_CPART) + (size_t)4 * 2048 * 128, (const float*)(ws + WS_BIAS) + 2048, (bf16_t*)(ws + WS_G1V), bid - 8);
            asm volatile("s_waitcnt vmcnt(0)" ::: "memory"); __syncthreads();
            pg8::Gemm g{(const bf16_t*)(ws + WS_G1V), (const bf16_t*)(ws + WS_WC2V), 2048, 256, 256, 256}; g.ldb = 256;
            EpiCmp2<1> E{(bf16_t*)(ws + WS_VCT)};
            pg8::gemm_phase<EpiCmp2<1>, pg8::StaticOrder, true, true>(l3, g, S, E);
        }
        if (bid >= 16) convert_w<0>(p.f2_w_out, FF_, D_, (bf16_t*)(ws + WS_WFOUT), FF_, D_, (unsigned*)lds, bid - 16, G - 16);
    }
    xcd_barrier(xbar);
    if (IN(7) && !SKIP(7)) {
        for (int k = 0;; ++k) {
            const int idx = (k & 1) ? (k + 1) * G - 1 - bid : k * G + bid;
            if (k * G >= 512) break;
            if (idx >= 512 || idx < 0) continue;
            const int qb = 63 - (idx >> 3), bg = idx & 7;
            nsa_item(ws, lds, bg >> 1, bg & 1, qb, (bf16_t*)(ws + WS_QNSA));
        }
    }
    xcd_barrier(xbar);
    if (IN(8) && !SKIP(8)) {
        {
            pg8::Gemm g{(const bf16_t*)(ws + WS_QSB), (const bf16_t*)(ws + WS_WSB), T_, D_, 1024, 1024}; pg8::StaticOrder S; S.init(T_, D_, G, bid);
            EpiBranch<0> E{Hb, (const bf16_t*)(ws + WS_Y)};
            pg8::gemm_phase<EpiBranch<0>, pg8::StaticOrder, true, true>(l3, g, S, E);
        }
        {
            pg8::Gemm g{(const bf16_t*)(ws + WS_QNSA), (const bf16_t*)(ws + WS_WNSA), T_, D_, 1024, 1024}; pg8::StaticOrder S; S.init(T_, D_, G, bid);
            EpiBranch<1> E{Hb, (const bf16_t*)(ws + WS_Y)};
            pg8::gemm_phase<EpiBranch<1>, pg8::StaticOrder, true, true>(l3, g, S, E);
        }
    }
    xcd_barrier(xbar);
    if (IN(9) && !SKIP(9)) {
        pg8::Gemm g{Hb, (const bf16_t*)(ws + WS_WOUT), T_, D_, D_, D_}; pg8::StaticOrder S; S.init(T_, D_, G, bid);
        pg8::EpiBf16<0> E{(bf16_t*)Yb, D_, nullptr, 0, 0};
        pg8::gemm_phase<pg8::EpiBf16<0>, pg8::StaticOrder, true, true>(l3, g, S, E);
    }
    xcd_barrier(xbar);
    if (IN(10) && !SKIP(10)) rowwise<1, true, true, true>(Yb, p.out, (bf16_t*)(ws + WS_Y) + (size_t)T_ * D_, (bf16_t*)(ws + WS_RS3), p.mix_post_g, p.f2_pre_g, 1.0f, bid, G);
    xcd_barrier(xbar);
    if (IN(11) && !SKIP(11)) {
        pg8::Gemm g{(const bf16_t*)(ws + WS_Y) + (size_t)T_ * D_, (const bf16_t*)(ws + WS_WFIN), T_, 2 * FF_, D_, D_}; pg8::StaticOrder S; S.init(T_, 2 * FF_, G, bid);
        EpiSwigluT<true> E{ACT, (const float*)(ws + WS_RS3)};
        pg8::gemm_phase<EpiSwigluT<true>, pg8::StaticOrder, true, true>(l3, g, S, E);
    }
    xcd_barrier(xbar);
    if (IN(12) && !SKIP(12)) {
        pg8::Gemm g{ACT, (const bf16_t*)(ws + WS_WFOUT), T_, D_, FF_, FF_}; pg8::StaticOrder S; S.init(T_, D_, G, bid);
        pg8::EpiBf16<0> E{(bf16_t*)Yb, D_, nullptr, 0, 0};
        pg8::gemm_phase<pg8::EpiBf16<0>, pg8::StaticOrder, true, true>(l3, g, S, E);
    }
    xcd_barrier(xbar);
    if (IN(13) && !SKIP(13)) rowwise<2, true, false>(Yb, (const bf16_t*)(ws + WS_Y) + (size_t)T_ * D_, p.out, nullptr, p.f2_post_g, nullptr, 0.5f, bid, G);
#undef IN
#undef SEAM
}

extern "C" void kernel_launch(void* const* d_in, const int* in_sizes, int n_in, void* d_out, int out_size, void* d_ws, size_t ws_size, hipStream_t stream) {
    static int grid = 0;
    if (grid == 0) {
        if (n_in != 21 || ws_size < mk::WS_END) { fprintf(stderr, "kernel_launch: unexpected n_in %d or ws_size %zu (need %zu)\n", n_in, ws_size, (size_t)mk::WS_END); grid = -1; return; }
        int dev = 0, cus = 0, per_cu = 0;
        hipGetDevice(&dev);
        hipDeviceGetAttribute(&cus, hipDeviceAttributeMultiprocessorCount, dev);
        if (hipFuncSetAttribute((const void*)mega_fwd, hipFuncAttributeMaxDynamicSharedMemorySize, mk::LDS_BYTES) != hipSuccess) { fprintf(stderr, "kernel_launch: hipFuncSetAttribute failed\n"); grid = -1; return; }
        if (hipOccupancyMaxActiveBlocksPerMultiprocessor(&per_cu, (const void*)mega_fwd, 512, mk::LDS_BYTES) != hipSuccess || per_cu < 1) { (void)hipGetLastError(); per_cu = 1; }
        grid = cus * per_cu;
        fprintf(stderr, "kernel_launch: grid %d (cus %d per_cu %d) ws %zu\n", grid, cus, per_cu, ws_size);
    }
    if (grid < 0) return;
    Params p{};
    const float** f = (const float**)&p;
    for (int i = 0; i < 21; ++i) f[i] = (const float*)d_in[i];
    p.out = (float*)d_out; p.ws = (unsigned char*)d_ws; p.phmask = 0x3fffu;
    if (hipMemsetAsync((char*)d_ws + mk::WS_BAR, 0, XCD_BAR_WORDS * 4, stream) != hipSuccess) { fprintf(stderr, "kernel_launch: memset of barrier words failed\n"); return; }
    void* args[] = {&p};
    hipError_t e = hipLaunchCooperativeKernel((const void*)mega_fwd, dim3(grid), dim3(512), args, mk::LDS_BYTES, stream);
    if (e != hipSuccess) fprintf(stderr, "cooperative launch failed: %s (grid %d)\n", hipGetErrorString(e), grid);
}
```

```cpp
#include <hip/hip_runtime.h>
#include <hip/hip_cooperative_groups.h>
#include <cstdio>
namespace cg = cooperative_groups;

#define XB_TMO      128
#define XB_XCNT(j)  (256  + 64 * (j))
#define XB_XSUB(j)  (1280 + 64 * (j))
#define XB_XGEN(j)  (2304 + 64 * (j))
#define XB_TOP      3328
#define XB_TOPGEN   3392
#define XCD_BAR_WORDS 3456
#define XB_SPIN_CAP (1u << 18)
#define XB_LAS __attribute__((address_space(3)))

__device__ __forceinline__ unsigned xb_ld(unsigned* p)              { return __hip_atomic_load(p, __ATOMIC_RELAXED, __HIP_MEMORY_SCOPE_AGENT); }
__device__ __forceinline__ unsigned xb_add(unsigned* p, unsigned v) { return __hip_atomic_fetch_add(p, v, __ATOMIC_RELAXED, __HIP_MEMORY_SCOPE_AGENT); }
__device__ __forceinline__ unsigned xb_xcc_id() { return (unsigned)__builtin_amdgcn_s_getreg((3 << 11) | 20) & 0xFu; }
#define XB_SPIN(cond, bar) do { unsigned _sp = 0; while (cond) { __builtin_amdgcn_s_sleep(1); \
    if ((++_sp & 255u) == 0u) { if (xb_ld(&(bar)[XB_TMO])) break; if (_sp > XB_SPIN_CAP) { atomicAdd(&(bar)[XB_TMO], 1u); break; } } } } while (0)

struct XcdBarrier {
    unsigned* bar; unsigned x;
    volatile XB_LAS unsigned* st;
};

__device__ __forceinline__ XcdBarrier xcd_barrier_post(unsigned* bar, volatile XB_LAS unsigned* st) {
    XcdBarrier b; b.bar = bar; b.x = xb_xcc_id(); b.st = st;
    if (threadIdx.x == 0) (void)xb_add(&bar[XB_XCNT(b.x)], 1u);
    return b;
}
__device__ __forceinline__ void xcd_barrier_complete(unsigned* bar, unsigned x, unsigned& nloc, unsigned& nx) {
    const unsigned G = gridDim.x * gridDim.y * gridDim.z;
    unsigned sum, cnt, mine, sp = 0u;
    for (;;) {
        sum = 0u; cnt = 0u; mine = 0u;
#pragma unroll
        for (unsigned j = 0; j < 16; ++j) { const unsigned c = xb_ld(&bar[XB_XCNT(j)]); sum += c; cnt += (c > 0u) ? 1u : 0u; mine = (j == x) ? c : mine; }
        if (sum == G) break;
        __builtin_amdgcn_s_sleep(1);
        if ((++sp & 255u) == 0u) { if (xb_ld(&bar[XB_TMO])) break; if (sp > XB_SPIN_CAP) { atomicAdd(&bar[XB_TMO], 1u); break; } }
    }
    nloc = mine > 0u ? mine : 1u; nx = cnt > 0u ? cnt : 1u;
}

__device__ __forceinline__ void xcd_barrier(const XcdBarrier& b) {
    asm volatile("s_waitcnt vmcnt(0)" ::: "memory");
    __syncthreads();
    if (threadIdx.x == 0) {
        unsigned* bar = b.bar;
        __builtin_amdgcn_s_waitcnt(0);
        unsigned nloc = b.st[0], nx = b.st[1];
        if (nloc == 0u) { xcd_barrier_complete(bar, b.x, nloc, nx); b.st[0] = nloc; b.st[1] = nx; }
        const unsigned old = xb_add(&bar[XB_XSUB(b.x)], 1u);
        const unsigned gen = old / nloc;
        if (old + 1u == (gen + 1u) * nloc) {
            __builtin_amdgcn_fence(__ATOMIC_RELEASE, "agent");
            asm volatile("s_waitcnt vmcnt(0)" ::: "memory");
            const unsigned og = xb_add(&bar[XB_TOP], 1u);
            const unsigned tg = og / nx;
            if (og + 1u == (tg + 1u) * nx) xb_add(&bar[XB_TOPGEN], 1u);
            else XB_SPIN(xb_ld(&bar[XB_TOPGEN]) == tg, bar);
            __builtin_amdgcn_fence(__ATOMIC_ACQUIRE, "agent");
            xb_add(&bar[XB_XGEN(b.x)], 1u);
            asm volatile("s_waitcnt vmcnt(0)" ::: "memory");
        } else {
            XB_SPIN(xb_ld(&bar[XB_XGEN(b.x)]) == gen, bar);
            __builtin_amdgcn_fence(__ATOMIC_ACQUIRE, "agent");
            asm volatile("s_waitcnt vmcnt(0)" ::: "memory");
        }
    }
    __syncthreads();
}


namespace pg8 {
#define PG8_LAS __attribute__((address_space(3)))
typedef unsigned short bf16_t;
typedef short bf16x8 __attribute__((ext_vector_type(8)));
typedef float f32x4 __attribute__((ext_vector_type(4)));
typedef unsigned u32x4 __attribute__((ext_vector_type(4)));
constexpr int BM = 256, BK = 64, HALF = 128, HTB = HALF * BK * 2  , STAGE_BYTES = 8 * HTB, NXCD = 8, WGM = 8;

__host__ __device__ __forceinline__ int lds_byte(int r, int c) { const int st = (r >> 4) * 2 + (c >> 5), rr = r & 15, cc = c & 31, ob = rr * 64 + cc * 2; return st * 1024 + (ob ^ (((ob >> 9) & 1) << 5)); }
__host__ __device__ __forceinline__ void stage_rc(int b, int& R, int& C) { const int st = b / 1024, sb = b % 1024, swz = sb ^ (((sb >> 9) & 1) << 5); R = (st >> 1) * 16 + swz / 64; C = (st & 1) * 32 + (swz % 64) / 2; }
__host__ __device__ __forceinline__ int perm32(int rho) { const int n = rho >> 4, i = rho & 15; return 8 * (i >> 2) + 4 * n + (i & 3); }

struct Unit { int pm, pn; };
struct Gemm { const bf16_t* A; const bf16_t* Bt; int M, N, K, lda; int ldb = 0; };

struct StaticOrder {
    int nM, nN, nwg, G, c;
    __host__ __device__ void init(int M, int N, int G_, int c_) { nM = M / BM; nN = N / BM; nwg = nM * nN; G = G_; c = c_; }
    __host__ __device__ bool next(int i, Unit& u) const {
        const long L = (long)i * G + c; if (L >= nwg) return false;
        int wgid = (int)L; { const int q = nwg / NXCD, r = nwg % NXCD, xcd = wgid % NXCD, off = wgid / NXCD; wgid = (xcd < r ? xcd * (q + 1) : r * (q + 1) + (xcd - r) * q) + off; }
        const int nig = WGM * nN, gid = wgid / nig, fm = gid * WGM, gsz = (nM - fm) < WGM ? (nM - fm) : WGM;
        u.pm = fm + ((wgid % nig) % gsz); u.pn = (wgid % nig) / gsz; return true;
    }
    __device__ __forceinline__ void a_ready(const Unit&) const {}
    __device__ __forceinline__ void done(const Unit&) const {}
};
struct CountedOrder : StaticOrder {
    const unsigned* ready; unsigned need; unsigned* tmo;
    __device__ __forceinline__ void a_ready(const Unit& u) const {
        if (threadIdx.x < 64) {
            const unsigned long long t0 = __builtin_amdgcn_s_memrealtime(); unsigned polls = 0;
            while ((unsigned)__builtin_amdgcn_readfirstlane(__hip_atomic_load(ready + 64 * u.pm, __ATOMIC_RELAXED, __HIP_MEMORY_SCOPE_AGENT)) < need) {
                if ((++polls & 255u) == 0u && __builtin_amdgcn_readfirstlane(__hip_atomic_load(tmo, __ATOMIC_RELAXED, __HIP_MEMORY_SCOPE_AGENT)) != 0u) break;
                if (__builtin_amdgcn_s_memrealtime() - t0 > 2000000ull) {
                    if (threadIdx.x == 0) { unsigned expect = 0u; __hip_atomic_compare_exchange_strong(tmo + 1, &expect, 0x600u | (unsigned)(u.pm & 0xff), __ATOMIC_RELAXED, __ATOMIC_RELAXED, __HIP_MEMORY_SCOPE_AGENT); __hip_atomic_store(tmo, 1u, __ATOMIC_RELAXED, __HIP_MEMORY_SCOPE_AGENT); }
                    break; }
                __builtin_amdgcn_s_sleep(2); }
            __builtin_amdgcn_fence(__ATOMIC_ACQUIRE, "agent");
            asm volatile("s_waitcnt vmcnt(0)" ::: "memory");
        }
#if !defined(BROKEN_HOOK_NO_BARRIER)
        asm volatile("" ::: "memory"); __builtin_amdgcn_s_barrier(); asm volatile("" ::: "memory");
#endif
    }
};

__device__ __forceinline__ unsigned cvt_pk_bf16(float lo, float hi) { unsigned r; asm volatile("v_cvt_pk_bf16_f32 %0, %1, %2" : "=v"(r) : "v"(lo), "v"(hi)); return r; }
typedef float f32x2 __attribute__((ext_vector_type(2)));
__device__ __forceinline__ f32x2 gelu_pk(f32x2 v) {
    const f32x2 av = __builtin_elementwise_abs(v), d = av * 0.2316418882f + 1.0f;
    f32x2 t; t.x = __builtin_amdgcn_rcpf(d.x); t.y = __builtin_amdgcn_rcpf(d.y);
    f32x2 q = t * 0.5307027145f + (-0.7265760135f); q = q * t + 0.7107068705f; q = q * t + (-0.142248368f); q = q * t + 0.127414796f; q = q * t;
    const f32x2 s = (v * v) * (-0.72134752044f);
    f32x2 e; e.x = __builtin_amdgcn_exp2f(s.x); e.y = __builtin_amdgcn_exp2f(s.y);
    const f32x2 m = v * (q * e), r = v - m;
    f32x2 o; o.x = v.x < 0.f ? m.x : r.x; o.y = v.y < 0.f ? m.y : r.y; return o;
}

struct EpiF32 {
    static constexpr bool PERM = false, AFTER_DRAIN = false;
    float* C; int ldc; const float* bias;
    __device__ __forceinline__ void operator()(const f32x4 (&acc)[2][2][4][2], const Unit& u, int wr, int wc, int fr, int fq) const {
        const int row0 = u.pm * BM + wr * 64 + fr, col0 = u.pn * BM + wc * 32 + 4 * fq;
        f32x4 bv[2][2];
#pragma unroll
        for (int bj = 0; bj < 2; ++bj)
#pragma unroll
            for (int n = 0; n < 2; ++n) bv[bj][n] = bias ? *(const f32x4*)(bias + col0 + bj * HALF + n * 16) : (f32x4){0.f, 0.f, 0.f, 0.f};
#pragma unroll
        for (int ai = 0; ai < 2; ++ai)
#pragma unroll
            for (int m = 0; m < 4; ++m) { float* rowp = C + (size_t)(row0 + ai * HALF + m * 16) * ldc + col0;
#pragma unroll
                for (int bj = 0; bj < 2; ++bj)
#pragma unroll
                    for (int n = 0; n < 2; ++n) *(f32x4*)(rowp + bj * HALF + n * 16) = acc[ai][bj][m][n] + bv[bj][n]; }
    }
};
template <int ACT  > struct EpiBf16 {
    static constexpr bool PERM = true, AFTER_DRAIN = false;
    bf16_t* O; int ldc; const float* bias; int split_cols; size_t split_stride;
    __device__ __forceinline__ void operator()(const f32x4 (&acc)[2][2][4][2], const Unit& u, int wr, int wc, int fr, int fq) const {
        const int row0 = u.pm * BM + wr * 64 + fr; int colt = u.pn * BM; bf16_t* base = O;
        if (split_cols) { const int t = colt / split_cols; base += (size_t)t * split_stride; colt -= t * split_cols; }
        const int col0 = colt + wc * 32 + 8 * fq, bcol0 = u.pn * BM + wc * 32 + 8 * fq;
        f32x4 bv[2][2];
#pragma unroll
        for (int bj = 0; bj < 2; ++bj)
#pragma unroll
            for (int n = 0; n < 2; ++n) bv[bj][n] = bias ? *(const f32x4*)(bias + bcol0 + bj * HALF + 4 * n) : (f32x4){0.f, 0.f, 0.f, 0.f};
#pragma unroll
        for (int ai = 0; ai < 2; ++ai)
#pragma unroll
            for (int m = 0; m < 4; ++m) { bf16_t* rowp = base + (size_t)(row0 + ai * HALF + m * 16) * ldc + col0;
#pragma unroll
                for (int bj = 0; bj < 2; ++bj) { f32x4 v0 = acc[ai][bj][m][0] + bv[bj][0], v1 = acc[ai][bj][m][1] + bv[bj][1];
                    if (ACT == 1) { f32x2 a = gelu_pk((f32x2){v0[0], v0[1]}), b = gelu_pk((f32x2){v0[2], v0[3]}), c = gelu_pk((f32x2){v1[0], v1[1]}), d = gelu_pk((f32x2){v1[2], v1[3]});
                        v0 = (f32x4){a.x, a.y, b.x, b.y}; v1 = (f32x4){c.x, c.y, d.x, d.y}; }
                    if (ACT == 2) {
#pragma unroll
                        for (int j = 0; j < 4; ++j) { v0[j] = 0.5f * v0[j] * (1.0f + erff(v0[j] * 0.70710678f)); v1[j] = 0.5f * v1[j] * (1.0f + erff(v1[j] * 0.70710678f)); } }
                    u32x4 w; w.x = cvt_pk_bf16(v0[0], v0[1]); w.y = cvt_pk_bf16(v0[2], v0[3]); w.z = cvt_pk_bf16(v1[0], v1[1]); w.w = cvt_pk_bf16(v1[2], v1[3]);
                    *(u32x4*)(rowp + bj * HALF) = w; } }
    }
};

template <class Epi, class Sched, bool ALIGN_EPI = false, bool SP2 = false>
__device__ __forceinline__ void gemm_phase(PG8_LAS unsigned char* lds, const Gemm g, const Sched& S, const Epi& E) {
    const int tid = threadIdx.x, wid = __builtin_amdgcn_readfirstlane(tid >> 6), lane = tid & 63, wr = wid >> 2, wc = wid & 3, fr = lane & 15, fq = lane >> 4;
    const int K = g.K, nt = K / BK; const int LDB = g.ldb ? g.ldb : g.K;
    unsigned voffA[2], voffB[2];
#pragma unroll
    for (int i = 0; i < 2; ++i) { int R, C; stage_rc(tid * 16 + i * 8192, R, C); const int Rb = Epi::PERM ? ((R & ~31) + perm32(R & 31)) : R;
        voffA[i] = (unsigned)(R * g.lda + C) * 2u; voffB[i] = (unsigned)(Rb * LDB + C) * 2u; }
    const size_t kstep = (size_t)(BK * 2);
    const size_t hstep = (size_t)HALF * LDB * 2;
    const size_t tstep = 2 * hstep; const size_t hstepA = (size_t)HALF * g.lda * 2; const size_t tstepA = 2 * hstepA;
    const unsigned ldsw = (unsigned)wid * 1024u;
    const int aoff = lds_byte(wr * 64 + fr, fq * 8), boff = lds_byte(wc * 32 + fr, fq * 8);
#define PG8_SA(b, h) (((b) * 2 + (h)) * HTB)
#define PG8_SB(b, h) ((4 + (b) * 2 + (h)) * HTB)
#define PG8_STAGE(bufoff, gbase, voff) do { _Pragma("unroll") for (int _i = 0; _i < 2; ++_i) \
        __builtin_amdgcn_global_load_lds((const unsigned*)((const char*)(gbase) + (voff)[_i]), (PG8_LAS unsigned*)(lds + (bufoff) + ldsw + _i * 8192), 16, 0, 0); } while (0)
#define PG8_LDA(dst, b, h) do { _Pragma("unroll") for (int m = 0; m < 4; ++m) _Pragma("unroll") for (int k = 0; k < 2; ++k) dst[m][k] = *(const PG8_LAS bf16x8*)(lds + PG8_SA(b, h) + aoff + m * 2048 + k * 1024); } while (0)
#define PG8_LDB(dst, b, h) do { _Pragma("unroll") for (int n = 0; n < 2; ++n) _Pragma("unroll") for (int k = 0; k < 2; ++k) dst[n][k] = *(const PG8_LAS bf16x8*)(lds + PG8_SB(b, h) + boff + n * 2048 + k * 1024); } while (0)
#define PG8_MMA(ai, bj, At, Bt) do { __builtin_amdgcn_s_setprio(1); _Pragma("unroll") for (int m = 0; m < 4; ++m) _Pragma("unroll") for (int n = 0; n < 2; ++n) _Pragma("unroll") for (int k = 0; k < 2; ++k) \
        acc[ai][bj][m][n] = __builtin_amdgcn_mfma_f32_16x16x32_bf16(Bt[n][k], At[m][k], acc[ai][bj][m][n], 0, 0, 0); __builtin_amdgcn_s_setprio(0); } while (0)
#define PG8_WAIT_V(n) asm volatile("s_waitcnt vmcnt(" #n ")" ::: "memory")
#define PG8_WAIT_L(n) asm volatile("s_waitcnt lgkmcnt(" #n ")" ::: "memory")
#define PG8_BAR __builtin_amdgcn_s_barrier()
#define PG8_SCHED __builtin_amdgcn_sched_barrier(0)
    Unit cur, nxt; int ui = 0;
    if (!S.next(0, cur)) return;
    f32x4 acc[2][2][4][2];
#pragma unroll
    for (int a = 0; a < 2; ++a)
#pragma unroll
        for (int b = 0; b < 2; ++b)
#pragma unroll
            for (int m = 0; m < 4; ++m)
#pragma unroll
                for (int n = 0; n < 2; ++n) acc[a][b][m][n] = (f32x4){0.f, 0.f, 0.f, 0.f};
    bf16x8 At[4][2], B0[2][2], B1[2][2];
    const char* cA = (const char*)g.A + (size_t)cur.pm * tstepA; const char* cB = (const char*)g.Bt + (size_t)cur.pn * tstep;
    S.a_ready(cur);
    if constexpr (SP2) {
        PG8_STAGE(PG8_SB(0, 0), cB, voffB); PG8_STAGE(PG8_SB(0, 1), cB + hstep, voffB); PG8_STAGE(PG8_SA(0, 0), cA, voffA); PG8_STAGE(PG8_SA(0, 1), cA + hstepA, voffA);
        if (wr == 1) PG8_BAR;
        PG8_WAIT_V(2); PG8_BAR;
        PG8_STAGE(PG8_SB(1, 0), cB + kstep, voffB); PG8_STAGE(PG8_SA(1, 0), cA + kstep, voffA); PG8_STAGE(PG8_SB(1, 1), cB + hstep + kstep, voffB);
        PG8_WAIT_V(6); PG8_BAR;
    } else {
        PG8_STAGE(PG8_SB(0, 0), cB, voffB); PG8_STAGE(PG8_SA(0, 0), cA, voffA); PG8_STAGE(PG8_SB(0, 1), cB + hstep, voffB); PG8_STAGE(PG8_SA(0, 1), cA + hstepA, voffA);
        if (wr == 1) PG8_BAR;
        PG8_WAIT_V(4); PG8_BAR;
        PG8_STAGE(PG8_SB(1, 0), cB + kstep, voffB); PG8_STAGE(PG8_SA(1, 0), cA + kstep, voffA); PG8_STAGE(PG8_SB(1, 1), cB + hstep + kstep, voffB);
        PG8_WAIT_V(6); PG8_BAR;
    }
    for (;;) {
        const bool has_next = S.next(ui + 1, nxt);
        const char* nA = has_next ? (const char*)g.A + (size_t)nxt.pm * tstepA : cA; const char* nB = has_next ? (const char*)g.Bt + (size_t)nxt.pn * tstep : cB;
        for (int t = 0; t < nt; t += 2) {
            const bool last = (t == nt - 2);
            const char* a1 = cA + (size_t)(t + 1) * kstep;
            const char* a2 = last ? nA : cA + (size_t)(t + 2) * kstep; const char* b2 = last ? nB : cB + (size_t)(t + 2) * kstep;
            const char* a3 = a2 + kstep; const char* b3 = b2 + kstep;
            if (last && has_next) S.a_ready(nxt);
            if constexpr (SP2) {
            PG8_LDB(B0, 0, 0); PG8_LDB(B1, 0, 1); PG8_SCHED; PG8_LDA(At, 0, 0); PG8_STAGE(PG8_SA(1, 1), a1 + hstepA, voffA);
            PG8_WAIT_V(8); PG8_WAIT_L(0); PG8_BAR; PG8_MMA(0, 0, At, B0); PG8_MMA(0, 1, At, B1); PG8_BAR; PG8_SCHED;
            PG8_LDA(At, 0, 1); PG8_STAGE(PG8_SB(0, 0), b2, voffB); PG8_STAGE(PG8_SB(0, 1), b2 + hstep, voffB); PG8_STAGE(PG8_SA(0, 0), a2, voffA);
            PG8_WAIT_V(8); PG8_WAIT_L(0); PG8_BAR; PG8_MMA(1, 0, At, B0); PG8_MMA(1, 1, At, B1); PG8_BAR; PG8_SCHED;
            PG8_LDB(B0, 1, 0); PG8_LDB(B1, 1, 1); PG8_SCHED; PG8_LDA(At, 1, 0); PG8_STAGE(PG8_SA(0, 1), a2 + hstepA, voffA);
            PG8_WAIT_V(8); PG8_WAIT_L(0); PG8_BAR; PG8_MMA(0, 0, At, B0); PG8_MMA(0, 1, At, B1); PG8_BAR; PG8_SCHED;
            PG8_LDA(At, 1, 1); PG8_STAGE(PG8_SB(1, 0), b3, voffB); PG8_STAGE(PG8_SB(1, 1), b3 + hstep, voffB); PG8_STAGE(PG8_SA(1, 0), a3, voffA);
            PG8_WAIT_V(8); PG8_WAIT_L(0); PG8_BAR; PG8_MMA(1, 0, At, B0); PG8_MMA(1, 1, At, B1); PG8_BAR; PG8_SCHED;
            } else {
            PG8_LDB(B0, 0, 0); PG8_SCHED; PG8_LDA(At, 0, 0); PG8_STAGE(PG8_SA(1, 1), a1 + hstepA, voffA);
            PG8_WAIT_L(8); PG8_BAR; PG8_WAIT_L(0); PG8_MMA(0, 0, At, B0); PG8_BAR; PG8_SCHED;
            PG8_LDB(B1, 0, 1); PG8_STAGE(PG8_SB(0, 0), b2, voffB);
            PG8_BAR; PG8_WAIT_L(0); PG8_MMA(0, 1, At, B1); PG8_BAR;
            PG8_LDA(At, 0, 1); PG8_STAGE(PG8_SA(0, 0), a2, voffA);
            PG8_BAR; PG8_WAIT_L(0); PG8_MMA(1, 0, At, B0); PG8_BAR; PG8_SCHED;
            PG8_STAGE(PG8_SB(0, 1), b2 + hstep, voffB);
            PG8_WAIT_V(6); PG8_BAR; PG8_MMA(1, 1, At, B1); PG8_BAR;
            PG8_LDB(B0, 1, 0); PG8_SCHED; PG8_LDA(At, 1, 0); PG8_STAGE(PG8_SA(0, 1), a2 + hstepA, voffA);
            PG8_WAIT_L(8); PG8_BAR; PG8_WAIT_L(0); PG8_MMA(0, 0, At, B0); PG8_BAR; PG8_SCHED;
            PG8_LDB(B1, 1, 1); PG8_STAGE(PG8_SB(1, 0), b3, voffB);
            PG8_BAR; PG8_WAIT_L(0); PG8_MMA(0, 1, At, B1); PG8_BAR;
            PG8_LDA(At, 1, 1); PG8_STAGE(PG8_SA(1, 0), a3, voffA);
            PG8_BAR; PG8_WAIT_L(0); PG8_MMA(1, 0, At, B0); PG8_BAR; PG8_SCHED;
            PG8_STAGE(PG8_SB(1, 1), b3 + hstep, voffB);
            PG8_WAIT_V(6); PG8_BAR; PG8_MMA(1, 1, At, B1); PG8_BAR;
            }
        }
        if constexpr (ALIGN_EPI) { if (wr == 0) PG8_BAR; }
        if constexpr (!Epi::AFTER_DRAIN) { E(acc, cur, wr, wc, fr, fq); S.done(cur); }
        if (!has_next) break;
#pragma unroll
        for (int a = 0; a < 2; ++a)
#pragma unroll
            for (int b = 0; b < 2; ++b)
#pragma unroll
                for (int m = 0; m < 4; ++m)
#pragma unroll
                    for (int n = 0; n < 2; ++n) acc[a][b][m][n] = (f32x4){0.f, 0.f, 0.f, 0.f};
        cur = nxt; cA = nA; cB = nB; ++ui;
        if constexpr (ALIGN_EPI) { if (wr == 1) PG8_BAR; }
    }
    PG8_WAIT_V(0);
    if constexpr (!ALIGN_EPI) { if (wr == 0) PG8_BAR; }
    PG8_BAR;
    if constexpr (Epi::AFTER_DRAIN) { E.fused(acc, cur, wr, wc, fr, fq, lds, wid, lane); S.done(cur); }
#undef PG8_SA
#undef PG8_SB
#undef PG8_STAGE
#undef PG8_LDA
#undef PG8_LDB
#undef PG8_MMA
#undef PG8_WAIT_V
#undef PG8_WAIT_L
#undef PG8_BAR
#undef PG8_SCHED
}
}
namespace mk {
typedef unsigned short bf16_t;
typedef short bf16x8 __attribute__((ext_vector_type(8)));
typedef short s16x4 __attribute__((ext_vector_type(4)));
typedef float f32x16 __attribute__((ext_vector_type(16)));
typedef float f32x4 __attribute__((ext_vector_type(4)));
typedef unsigned u32x4 __attribute__((ext_vector_type(4)));
typedef unsigned u32x2 __attribute__((ext_vector_type(2)));
#define DI __device__ __forceinline__

constexpr int B_ = 4, S_ = 4096, T_ = B_ * S_, D_ = 2048, FF_ = 5632, NVIN = 9984;
constexpr int NTHREADS = 512;
constexpr float EPS = 1e-6f;
constexpr float LOG2E = 1.4426950408889634f;
constexpr float QSCALE = 0.08838834764831845f;

constexpr size_t al(size_t x) { return (x + 4095) & ~(size_t)4095; }
constexpr size_t WS_WFIN = 0;
constexpr size_t WS_WFOUT = WS_WFIN + al((size_t)2 * FF_ * D_ * 2);
constexpr size_t WS_WIN = WS_WFOUT + al((size_t)D_ * FF_ * 2);
constexpr size_t WS_WSB = WS_WIN + al((size_t)NVIN * D_ * 2);
constexpr size_t WS_WNSA = WS_WSB + al((size_t)D_ * 1024 * 2);
constexpr size_t WS_WOUT = WS_WNSA + al((size_t)D_ * 1024 * 2);
constexpr size_t WS_WC1K = WS_WOUT + al((size_t)D_ * D_ * 2);
constexpr size_t WS_WC1V = WS_WC1K + al((size_t)256 * 4096 * 2);
constexpr size_t WS_WC2K = WS_WC1V + al((size_t)256 * 4096 * 2);
constexpr size_t WS_WC2V = WS_WC2K + al((size_t)256 * 256 * 2);
constexpr size_t WS_BIAS = WS_WC2V + al((size_t)256 * 256 * 2);
constexpr size_t WS_BAR = WS_BIAS + 16384;
#ifndef WS_SHIFT
#define WS_SHIFT 0
#endif
constexpr size_t WS_H = WS_BAR + 16384 + (size_t)WS_SHIFT;
constexpr size_t WS_Y = WS_H + al((size_t)T_ * D_ * 2);
constexpr size_t WS_ACT = WS_Y + al((size_t)T_ * D_ * 4);
constexpr size_t WS_QSB = WS_ACT;
constexpr size_t WS_KSB = WS_QSB + (size_t)T_ * 1024 * 2;
constexpr size_t WS_VTSB = WS_KSB + (size_t)T_ * 1024 * 2;
constexpr size_t WS_QNSA = WS_VTSB + (size_t)T_ * 1024 * 2;
constexpr size_t WS_KCK = WS_QNSA + (size_t)T_ * 1024 * 2;
constexpr size_t WS_KCV = WS_KCK + (size_t)T_ * 256 * 2 + 65536;
constexpr size_t WS_KSLC = WS_KCV + (size_t)T_ * 256 * 2 + 65536;
constexpr size_t WS_VTSLC = WS_KSLC + (size_t)T_ * 256 * 2;
constexpr size_t WS_KWIN = WS_VTSLC + (size_t)T_ * 256 * 2;
constexpr size_t WS_VTWIN = WS_KWIN + (size_t)T_ * 256 * 2;
constexpr size_t WS_GN = WS_VTWIN + (size_t)T_ * 256 * 2;
constexpr size_t WS_G1K = WS_GN + (size_t)T_ * 32 * 4;
constexpr size_t WS_G1V = WS_G1K + (size_t)2048 * 256 * 2;
constexpr size_t WS_KC = WS_G1V + (size_t)2048 * 256 * 2;
constexpr size_t WS_VCT = WS_KC + (size_t)2048 * 128 * 2;
constexpr size_t WS_CPART = WS_VCT + (size_t)2048 * 128 * 2;
constexpr size_t WS_MIXEND = WS_CPART + (size_t)8 * 2048 * 128 * 4;
constexpr size_t WS_ACTEND = WS_ACT + al((size_t)T_ * FF_ * 2);
constexpr size_t WS_RS2 = (WS_MIXEND > WS_ACTEND ? WS_MIXEND : WS_ACTEND) + 4096;
constexpr size_t WS_RS3 = WS_RS2 + (size_t)T_ * 4;
constexpr size_t WS_END = WS_RS3 + (size_t)T_ * 4 + 4096;
static_assert(WS_END <= (size_t)536870912, "workspace too large");

constexpr int LDS_BYTES = 132096;

struct Params {
    const float* x; const float* f1_pre_g; const float* f1_w_in; const float* f1_w_out; const float* f1_post_g;
    const float* mix_pre_g; const float* w_in; const float* cmp_pos_k; const float* cmp_k_w1; const float* cmp_k_w2;
    const float* cmp_pos_v; const float* cmp_v_w1; const float* cmp_v_w2; const float* w_branch_sb; const float* w_branch_nsa;
    const float* w_out; const float* mix_post_g; const float* f2_pre_g; const float* f2_w_in; const float* f2_w_out; const float* f2_post_g;
    float* out; unsigned char* ws; unsigned phmask, pad;
};

typedef __bf16 hwbf16x2 __attribute__((ext_vector_type(2)));
typedef float f32x2v __attribute__((ext_vector_type(2)));
DI unsigned pk2(float a, float b) {
    f32x2v v; v.x = a; v.y = b;
    return __builtin_bit_cast(unsigned, __builtin_convertvector(v, hwbf16x2));
}
DI bf16_t f2bf(float a) { unsigned ua = __float_as_uint(a); ua += 0x7fffu + ((ua >> 16) & 1u); return (bf16_t)(ua >> 16); }
DI float bf2f(bf16_t v) { return __uint_as_float(((unsigned)v) << 16); }
DI float wave_sum(float v) {
#pragma unroll
    for (int o = 32; o >= 1; o >>= 1) v += __shfl_xor(v, o);
    return v;
}
DI float sigmoidf_(float x) { return __builtin_amdgcn_rcpf(1.0f + __expf(-x)); }

template <int MAP> DI int map_col(int nv, int Nact) {
    if (MAP == 0) return nv < Nact ? nv : -1;
    if (MAP == 1) { const int p = nv >> 8, hh = (nv >> 7) & 1, i = nv & 127; return hh * FF_ + 128 * p + i; }
    if (nv < 2048) return nv;
    if (nv < 3584) return nv + 1024;
    if (nv < 3840) return 4608 + (nv - 3584);
    if (nv < 4096) return 5120 + (nv - 3840);
    if (nv < 8192) return 5656 + (nv - 4096);
    if (nv < 8216) return 5632 + (nv - 8192);
    if (nv < 8448) return -1;
    if (nv < 9472) return 2048 + (nv - 8448);
    if (nv < 9728) return 4864 + (nv - 9472);
    return 5376 + (nv - 9728);
}
template <int MAP> DI void convert_w(const float* __restrict__ W, int Kact, int Nact, bf16_t* __restrict__ Bt, int Kv, int Nv, unsigned* lds32, int bid, int G, const float* __restrict__ gk = nullptr, int t0 = 0, int t1 = -1) {
    const int tid = threadIdx.x;
    const int tk = Kv >> 7, tn = Nv >> 6, ntile = (t1 < 0) ? tk * tn : t1;
    const int n4 = (tid & 15) * 4, kq = tid >> 4;
    bid += t0;
    f32x4 va[2], vb[2];
    auto load_tile = [&](int tile) {
        const int n0 = (tile / tk) << 6, k0 = (tile % tk) << 7;
        const int col = map_col<MAP>(n0 + n4, Nact);
#pragma unroll
        for (int i = 0; i < 2; ++i) {
            const int k = k0 + 2 * (kq + 32 * i);
            va[i] = (f32x4){0.f, 0.f, 0.f, 0.f}; vb[i] = va[i];
            if (col >= 0 && k < Kact) { va[i] = __builtin_nontemporal_load((const f32x4*)(W + (size_t)k * Nact + col)); vb[i] = __builtin_nontemporal_load((const f32x4*)(W + (size_t)(k + 1) * Nact + col));
                if (gk) { va[i] *= gk[k]; vb[i] *= gk[k + 1]; } }
        }
    };
    if (bid < ntile) load_tile(bid);
    for (int tile = bid; tile < ntile; tile += G) {
        const int n0 = (tile / tk) << 6, k0 = (tile % tk) << 7;
#pragma unroll
        for (int i = 0; i < 2; ++i)
#pragma unroll
            for (int j = 0; j < 4; ++j) lds32[(n4 + j) * 65 + kq + 32 * i] = pk2(va[i][j], vb[i][j]);
        if (tile + G < ntile) load_tile(tile + G);
        __syncthreads();
#pragma unroll
        for (int i = 0; i < 2; ++i) {
            const int c = tid + 512 * i, row = c >> 4, ch = c & 15;
            u32x4 v; v.x = lds32[row * 65 + ch * 4 + 0]; v.y = lds32[row * 65 + ch * 4 + 1]; v.z = lds32[row * 65 + ch * 4 + 2]; v.w = lds32[row * 65 + ch * 4 + 3];
            *(u32x4*)(Bt + (size_t)(n0 + row) * Kv + k0 + ch * 8) = v;
        }
        __syncthreads();
    }
}
DI void cmp_bias_part(const float* __restrict__ pos, const float* __restrict__ w1, float* __restrict__ partial, int w, float* ldsf) {
    const int tid = threadIdx.x, n = tid & 127, part = tid >> 7;
    float s = 0.f;
    const int kb = w * 256 + part * 64;
#pragma unroll 8
    for (int k = kb; k < kb + 64; ++k) s += pos[k] * w1[(size_t)k * 128 + n];
    ldsf[tid] = s;
    __syncthreads();
    if (tid < 128) partial[w * 128 + tid] = (ldsf[tid] + ldsf[tid + 128]) + (ldsf[tid + 256] + ldsf[tid + 384]);
    __syncthreads();
}

template <int MODE, bool BASE_BF = false, bool XO_BF = false, bool HS = false> DI void rowwise(const float* __restrict__ y, const void* base, void* xo, bf16_t* __restrict__ hout,
                                    const float* __restrict__ gp, const float* __restrict__ g1, float fac, int bid, int G) {
    const int lane = threadIdx.x & 63, wave = threadIdx.x >> 6;
    for (int row = bid * 8 + wave; row < T_; row += G * 8) {
        f32x4 v[8];
        if (MODE == 0) {
#pragma unroll
            for (int i = 0; i < 8; ++i) v[i] = __builtin_nontemporal_load((const f32x4*)(y + (size_t)row * D_ + i * 256 + lane * 4));
        } else {
            u32x2 yw[8]; f32x4 bs[8]; u32x2 bw[8];
#pragma unroll
            for (int i = 0; i < 8; ++i) yw[i] = __builtin_nontemporal_load((const u32x2*)((const bf16_t*)y + (size_t)row * D_ + i * 256 + lane * 4));
#pragma unroll
            for (int i = 0; i < 8; ++i) {
                if (BASE_BF) bw[i] = __builtin_nontemporal_load((const u32x2*)((const bf16_t*)base + (size_t)row * D_ + i * 256 + lane * 4));
                else bs[i] = __builtin_nontemporal_load((const f32x4*)((const float*)base + (size_t)row * D_ + i * 256 + lane * 4));
            }
            float ss = 0.f;
#pragma unroll
            for (int i = 0; i < 8; ++i) {
                const u32x2 w = yw[i];
                v[i] = (f32x4){__uint_as_float(w.x << 16), __uint_as_float(w.x & 0xffff0000u), __uint_as_float(w.y << 16), __uint_as_float(w.y & 0xffff0000u)};
                ss += (v[i][0] * v[i][0] + v[i][1] * v[i][1]) + (v[i][2] * v[i][2] + v[i][3] * v[i][3]); }
            ss = wave_sum(ss);
            const float r = rsqrtf(ss * (1.0f / D_) + EPS) * fac;
#pragma unroll
            for (int i = 0; i < 8; ++i) {
                if (BASE_BF) { const u32x2 w = bw[i]; bs[i] = (f32x4){__uint_as_float(w.x << 16), __uint_as_float(w.x & 0xffff0000u), __uint_as_float(w.y << 16), __uint_as_float(w.y & 0xffff0000u)}; }
                const f32x4 gg = *(const f32x4*)(gp + i * 256 + lane * 4);
                v[i] = bs[i] + v[i] * r * gg;
                if (XO_BF) { u32x2 w; w.x = pk2(v[i][0], v[i][1]); w.y = pk2(v[i][2], v[i][3]); *(u32x2*)((bf16_t*)xo + (size_t)row * D_ + i * 256 + lane * 4) = w; }
                else if (MODE == 2) __builtin_nontemporal_store(v[i], (f32x4*)((float*)xo + (size_t)row * D_ + i * 256 + lane * 4));
                else *(f32x4*)((float*)xo + (size_t)row * D_ + i * 256 + lane * 4) = v[i];
            }
        }
        if (MODE != 2) {
            float ss = 0.f;
#pragma unroll
            for (int i = 0; i < 8; ++i) ss += (v[i][0] * v[i][0] + v[i][1] * v[i][1]) + (v[i][2] * v[i][2] + v[i][3] * v[i][3]);
            ss = wave_sum(ss);
            const float r = rsqrtf(ss * (1.0f / D_) + EPS);
            if (HS) { if (lane == 0) ((float*)hout)[row] = r; }
            else {
#pragma unroll
            for (int i = 0; i < 8; ++i) {
                const f32x4 gg = *(const f32x4*)(g1 + i * 256 + lane * 4);
                const f32x4 o = v[i] * r * gg;
                u32x2 w; w.x = pk2(o[0], o[1]); w.y = pk2(o[2], o[3]);
                *(u32x2*)(hout + (size_t)row * D_ + i * 256 + lane * 4) = w;
            }
            }
        }
    }
}

using pg8::Unit; using pg8::HALF; using pg8::BM;
struct EpiNull {
    static constexpr bool PERM = true, AFTER_DRAIN = false;
    float* sink; unsigned flag;
    DI void operator()(const f32x4 (&acc)[2][2][4][2], const Unit& u, int wr, int wc, int fr, int fq) const {
        if (flag == 0x1234u) {
            f32x4 t = (f32x4){0.f, 0.f, 0.f, 0.f};
#pragma unroll
            for (int ai = 0; ai < 2; ++ai)
#pragma unroll
                for (int bj = 0; bj < 2; ++bj)
#pragma unroll
                    for (int m = 0; m < 4; ++m)
#pragma unroll
                        for (int n = 0; n < 2; ++n) t += acc[ai][bj][m][n];
            *(f32x4*)(sink + threadIdx.x * 4) = t;
        }
    }
};
template <bool RS> struct EpiSwigluT {
    static constexpr bool PERM = true, AFTER_DRAIN = false;
    bf16_t* O; const float* rs;
    DI void operator()(const f32x4 (&acc)[2][2][4][2], const Unit& u, int wr, int wc, int fr, int fq) const {
        const int row0 = u.pm * BM + wr * 64 + fr, col0 = u.pn * 128 + wc * 32 + 8 * fq;
#pragma unroll
        for (int ai = 0; ai < 2; ++ai)
#pragma unroll
            for (int m = 0; m < 4; ++m) {
                float o[8];
                const float rr = RS ? rs[row0 + ai * HALF + m * 16] : 1.0f;
#pragma unroll
                for (int n = 0; n < 2; ++n)
#pragma unroll
                    for (int j = 0; j < 4; ++j) { const float gt = acc[ai][0][m][n][j] * rr, up = acc[ai][1][m][n][j] * rr; o[n * 4 + j] = gt * __builtin_amdgcn_rcpf(1.0f + __expf(-gt)) * up; }
                u32x4 w; w.x = pk2(o[0], o[1]); w.y = pk2(o[2], o[3]); w.z = pk2(o[4], o[5]); w.w = pk2(o[6], o[7]);
                *(u32x4*)(O + (size_t)(row0 + ai * HALF + m * 16) * FF_ + col0) = w;
            }
    }
};
typedef EpiSwigluT<false> EpiSwiglu;
struct EpiInprojA {
    static constexpr bool PERM = true, AFTER_DRAIN = false;
    unsigned char* ws; const float* rs;
    DI void operator()(const f32x4 (&acc)[2][2][4][2], const Unit& u, int wr, int wc, int fr, int fq) const {
        const int pn = __builtin_amdgcn_readfirstlane(u.pn);
        const int row0 = __builtin_amdgcn_readfirstlane(u.pm) * BM + wr * 64 + fr;
        const int cl0 = wc * 32 + 8 * fq;
        if (pn == 32) {
            float* gn = (float*)(ws + WS_GN);
            if (wc == 0) {
#pragma unroll
                for (int ai = 0; ai < 2; ++ai)
#pragma unroll
                    for (int m = 0; m < 4; ++m) {
                        const int r = row0 + ai * HALF + m * 16;
#pragma unroll
                        for (int n = 0; n < 2; ++n) { f32x4 v = acc[ai][0][m][n] * rs[r]; f32x4 o; for (int j = 0; j < 4; ++j) o[j] = sigmoidf_(v[j]); *(f32x4*)(gn + (size_t)r * 32 + cl0 + 4 * n) = o; }
                    }
            }
            return;
        }
        bf16_t* base; int pitch, cbase; bool sig = false, dense = false;
        if (pn < 4) { base = (bf16_t*)(ws + WS_QSB); pitch = 1024; cbase = pn * 256; }
        else if (pn < 8) { base = (bf16_t*)(ws + WS_KSB); pitch = 1024; cbase = (pn - 4) * 256; }
        else if (pn < 12) { base = (bf16_t*)(ws + WS_QNSA); pitch = 1024; cbase = (pn - 8) * 256; }
        else if (pn == 12) { base = (bf16_t*)(ws + WS_KCK); pitch = 128; cbase = 0; dense = true; }
        else if (pn == 13) { base = (bf16_t*)(ws + WS_KCV); pitch = 128; cbase = 0; dense = true; }
        else if (pn == 14) { base = (bf16_t*)(ws + WS_KSLC); pitch = 256; cbase = 0; }
        else if (pn == 15) { base = (bf16_t*)(ws + WS_KWIN); pitch = 256; cbase = 0; }
        else { base = (bf16_t*)(ws + WS_Y); pitch = 4096; cbase = (pn - 16) * 256; sig = true; }
#pragma unroll
        for (int ai = 0; ai < 2; ++ai)
#pragma unroll
            for (int m = 0; m < 4; ++m) {
                const int r = row0 + ai * HALF + m * 16;
                const float rr = rs[r];
#pragma unroll
                for (int bj = 0; bj < 2; ++bj) {
                    f32x4 v0 = acc[ai][bj][m][0] * rr, v1 = acc[ai][bj][m][1] * rr;
                    if (sig) { for (int j = 0; j < 4; ++j) { v0[j] = sigmoidf_(v0[j]); v1[j] = sigmoidf_(v1[j]); } }
                    u32x4 w; w.x = pk2(v0[0], v0[1]); w.y = pk2(v0[2], v0[3]); w.z = pk2(v1[0], v1[1]); w.w = pk2(v1[2], v1[3]);
                    const int c = bj * HALF + cl0;
                    size_t off;
                    if (dense) { const int b = r >> 12, s = r & 4095, g = c >> 7, d = c & 127; off = ((size_t)((b * 2 + g) * S_ + s)) * 128 + d; }
                    else off = (size_t)r * pitch + cbase + c;
                    *(u32x4*)(base + off) = w;
                }
            }
    }
};
struct EpiInprojB {
    static constexpr bool PERM = true, AFTER_DRAIN = false;
    unsigned char* ws; const float* rs;
    DI void operator()(const f32x4 (&acc)[2][2][4][2], const Unit& u, int wr, int wc, int fr, int fq) const {
        const int pn = __builtin_amdgcn_readfirstlane(u.pn);
        const int row0 = __builtin_amdgcn_readfirstlane(u.pm) * BM + wr * 64 + fr;
        const int cl0 = wc * 32 + 8 * fq;
        bf16_t* vt; int ncol, cbase;
        if (pn < 4) { vt = (bf16_t*)(ws + WS_VTSB); ncol = 1024; cbase = pn * 256; }
        else if (pn == 4) { vt = (bf16_t*)(ws + WS_VTSLC); ncol = 256; cbase = 0; }
        else { vt = (bf16_t*)(ws + WS_VTWIN); ncol = 256; cbase = 0; }
#pragma unroll
        for (int ai = 0; ai < 2; ++ai)
#pragma unroll
            for (int m = 0; m < 4; ++m) {
                const int r = row0 + ai * HALF + m * 16, b = r >> 12, s = r & 4095;
                bf16_t* pp = vt + ((size_t)(b * ncol + cbase + cl0)) * S_ + s;
                const float rr = rs[r];
#pragma unroll
                for (int bj = 0; bj < 2; ++bj) {
#pragma unroll
                    for (int n = 0; n < 2; ++n)
#pragma unroll
                        for (int j = 0; j < 4; ++j) { *pp = f2bf(acc[ai][bj][m][n][j] * rr); pp += S_; asm volatile("" : "+v"(pp)); }
                    pp += (size_t)(HALF - 8) * S_; asm volatile("" : "+v"(pp));
                }
            }
    }
};
DI float gelu_tanh(float x) { const float u = 0.7978845608028654f * (x + 0.044715f * x * x * x); const float e = __expf(2.0f * u); const float th = 1.0f - 2.0f / (e + 1.0f); return 0.5f * x * (1.0f + th); }
struct EpiPart {
    static constexpr bool PERM = false, AFTER_DRAIN = false;
    float* P;
    DI void operator()(const f32x4 (&acc)[2][2][4][2], const Unit& u, int wr, int wc, int fr, int fq) const {
        const int row0 = __builtin_amdgcn_readfirstlane(u.pm) * BM + wr * 64 + fr, c0 = wc * 32 + 4 * fq;
#pragma unroll
        for (int ai = 0; ai < 2; ++ai)
#pragma unroll
            for (int m = 0; m < 4; ++m) {
                float* rowp = P + (size_t)(row0 + ai * HALF + m * 16) * 128 + c0;
#pragma unroll
                for (int n = 0; n < 2; ++n) *(f32x4*)(rowp + n * 16) = acc[ai][0][m][n];
            }
    }
};
DI void cmp_g1_tile(const float* __restrict__ part, const float* __restrict__ biasp, bf16_t* __restrict__ G1, int pm) {
    const int tid = threadIdx.x, c4 = (tid & 31) * 4, r0 = tid >> 5;
    f32x4 bv = (f32x4){0.f, 0.f, 0.f, 0.f};
    for (int w = 0; w < 16; ++w) bv += *(const f32x4*)(biasp + w * 128 + c4);
    for (int rr = r0; rr < 256; rr += 16) {
        const size_t r = (size_t)pm * 256 + rr;
        f32x4 v = bv;
#pragma unroll
        for (int q = 0; q < 4; ++q) v += __builtin_nontemporal_load((const f32x4*)(part + (size_t)q * 2048 * 128 + r * 128 + c4));
        u32x2 w; w.x = pk2(gelu_tanh(v[0]), gelu_tanh(v[1])); w.y = pk2(gelu_tanh(v[2]), gelu_tanh(v[3]));
        *(u32x2*)(G1 + r * 256 + c4) = w;
        u32x2 z; z.x = 0u; z.y = 0u;
        *(u32x2*)(G1 + r * 256 + 128 + c4) = z;
    }
}
struct EpiCmp1 {
    static constexpr bool PERM = true, AFTER_DRAIN = false;
    bf16_t* O; const float* bias;
    DI void operator()(const f32x4 (&acc)[2][2][4][2], const Unit& u, int wr, int wc, int fr, int fq) const {
        const int row0 = u.pm * BM + wr * 64 + fr, cl0 = wc * 32 + 8 * fq;
        f32x4 b0 = (f32x4){0.f, 0.f, 0.f, 0.f}, b1 = b0;
        for (int w = 0; w < 16; ++w) { b0 += *(const f32x4*)(bias + w * 128 + cl0); b1 += *(const f32x4*)(bias + w * 128 + cl0 + 4); }
#pragma unroll
        for (int ai = 0; ai < 2; ++ai)
#pragma unroll
            for (int m = 0; m < 4; ++m) {
                const int r = row0 + ai * HALF + m * 16;
                f32x4 v0 = acc[ai][0][m][0] + b0, v1 = acc[ai][0][m][1] + b1;
                for (int j = 0; j < 4; ++j) { v0[j] = gelu_tanh(v0[j]); v1[j] = gelu_tanh(v1[j]); }
                u32x4 w; w.x = pk2(v0[0], v0[1]); w.y = pk2(v0[2], v0[3]); w.z = pk2(v1[0], v1[1]); w.w = pk2(v1[2], v1[3]);
                *(u32x4*)(O + (size_t)r * 256 + cl0) = w;
                u32x4 z; z.x = 0; z.y = 0; z.z = 0; z.w = 0;
                *(u32x4*)(O + (size_t)r * 256 + 128 + cl0) = z;
            }
    }
};
template <int TRANSP> struct EpiCmp2 {
    static constexpr bool PERM = true, AFTER_DRAIN = false;
    bf16_t* O;
    DI void operator()(const f32x4 (&acc)[2][2][4][2], const Unit& u, int wr, int wc, int fr, int fq) const {
        const int row0 = u.pm * BM + wr * 64 + fr, cl0 = wc * 32 + 8 * fq;
#pragma unroll
        for (int ai = 0; ai < 2; ++ai)
#pragma unroll
            for (int m = 0; m < 4; ++m) {
                const int r = row0 + ai * HALF + m * 16;
                const f32x4 v0 = acc[ai][0][m][0], v1 = acc[ai][0][m][1];
                if (TRANSP == 0) {
                    u32x4 w; w.x = pk2(v0[0], v0[1]); w.y = pk2(v0[2], v0[3]); w.z = pk2(v1[0], v1[1]); w.w = pk2(v1[2], v1[3]);
                    *(u32x4*)(O + (size_t)r * 128 + cl0) = w;
                } else {
#pragma unroll
                    for (int j = 0; j < 4; ++j) { O[((size_t)(u.pm * 128 + cl0 + j)) * 256 + (r & 255)] = f2bf(v0[j]); O[((size_t)(u.pm * 128 + cl0 + 4 + j)) * 256 + (r & 255)] = f2bf(v1[j]); }
                }
            }
    }
};
template <int SECOND> struct EpiBranch {
    static constexpr bool PERM = true, AFTER_DRAIN = false;
    bf16_t* Hh; const bf16_t* Gm;
    DI void operator()(const f32x4 (&acc)[2][2][4][2], const Unit& u, int wr, int wc, int fr, int fq) const {
        const int row0 = u.pm * BM + wr * 64 + fr, col0 = u.pn * BM + wc * 32 + 8 * fq;
#pragma unroll
        for (int ai = 0; ai < 2; ++ai)
#pragma unroll
            for (int m = 0; m < 4; ++m) {
                const int r = row0 + ai * HALF + m * 16;
#pragma unroll
                for (int bj = 0; bj < 2; ++bj) {
                    const int c = col0 + bj * HALF;
                    const u32x4 gw = __builtin_nontemporal_load((const u32x4*)(Gm + (size_t)r * 4096 + SECOND * 2048 + c));
                    float o[8];
#pragma unroll
                    for (int n = 0; n < 2; ++n)
#pragma unroll
                        for (int j = 0; j < 4; ++j) o[n * 4 + j] = acc[ai][bj][m][n][j];
                    const unsigned gws[4] = {gw.x, gw.y, gw.z, gw.w};
#pragma unroll
                    for (int q = 0; q < 4; ++q) { o[2 * q] *= __uint_as_float(gws[q] << 16); o[2 * q + 1] *= __uint_as_float(gws[q] & 0xffff0000u); }
                    if (SECOND) {
                        const u32x4 hw = __builtin_nontemporal_load((const u32x4*)(Hh + (size_t)r * D_ + c));
                        const unsigned hws[4] = {hw.x, hw.y, hw.z, hw.w};
#pragma unroll
                        for (int q = 0; q < 4; ++q) { o[2 * q] += __uint_as_float(hws[q] << 16); o[2 * q + 1] += __uint_as_float(hws[q] & 0xffff0000u); }
                    }
                    u32x4 w; w.x = pk2(o[0], o[1]); w.y = pk2(o[2], o[3]); w.z = pk2(o[4], o[5]); w.w = pk2(o[6], o[7]);
                    *(u32x4*)(Hh + (size_t)r * D_ + c) = w;
                }
            }
    }
};

constexpr int KPITCH = 272, VPITCH = 136, KBYTES = 64 * KPITCH, VBYTES = 128 * VPITCH, TILE_BYTES = KBYTES + VBYTES;
#define MFMA32(a, b, c) __builtin_amdgcn_mfma_f32_32x32x16_bf16((a), (b), (c), 0, 0, 0)
struct KVRegs { u32x4 k[2]; u32x4 v[2]; };
template <bool WITHV = true, bool NT = false> DI void kv_load(KVRegs& R, const bf16_t* Kp, unsigned kpitch, const bf16_t* Vp, unsigned vpitch, int tid) {
    asm volatile("" : "+v"(tid));
#pragma unroll
    for (int i = 0; i < 2; ++i) { const unsigned c = tid + 512 * i; const unsigned off = (c >> 4) * kpitch + (c & 15) * 8; R.k[i] = NT ? __builtin_nontemporal_load((const u32x4*)(Kp + off)) : *(const u32x4*)(Kp + off); }
    if (WITHV) {
#pragma unroll
    for (int i = 0; i < 2; ++i) { const unsigned c = tid + 512 * i; const unsigned off = (c >> 3) * vpitch + (c & 7) * 8; R.v[i] = NT ? __builtin_nontemporal_load((const u32x4*)(Vp + off)) : *(const u32x4*)(Vp + off); }
    }
}
template <bool WITHV = true> DI void kv_store(const KVRegs& R, unsigned char* buf, int tid) {
    asm volatile("" : "+v"(tid));
#pragma unroll
    for (int i = 0; i < 2; ++i) { const int c = tid + 512 * i; *(u32x4*)(buf + (c >> 4) * KPITCH + (c & 15) * 16) = R.k[i]; }
    if (WITHV) {
#pragma unroll
    for (int i = 0; i < 2; ++i) { const int c = tid + 512 * i; unsigned char* p = buf + KBYTES + (c >> 3) * VPITCH + (c & 7) * 16;
        u32x2 a; a.x = R.v[i].x; a.y = R.v[i].y; u32x2 b; b.x = R.v[i].z; b.y = R.v[i].w; *(u32x2*)p = a; *(u32x2*)(p + 8) = b; }
    }
}
DI void qk_tile(const unsigned char* kt, const bf16x8 (&qf)[8], f32x16 (&s)[2], int lane) {
    const int key = lane & 31, h = lane >> 5;
    const unsigned char* base = kt + key * KPITCH + h * 16;
#pragma unroll
    for (int kb = 0; kb < 2; ++kb) {
#pragma unroll
        for (int i = 0; i < 16; ++i) s[kb][i] = 0.f;
#pragma unroll
        for (int kg = 0; kg < 2; ++kg) {
            bf16x8 a[4];
#pragma unroll
            for (int q = 0; q < 4; ++q) a[q] = *(const bf16x8*)(base + kb * 32 * KPITCH + (kg * 4 + q) * 32);
#pragma unroll
            for (int q = 0; q < 4; ++q) s[kb] = MFMA32(a[q], qf[kg * 4 + q], s[kb]);
            __builtin_amdgcn_sched_barrier(0);
        }
    }
}
DI void pv_tile(const unsigned char* vt, const bf16x8 (&pf)[4], f32x16 (&o)[4], int lane) {
    const int dl = lane & 31, h = lane >> 5;
    const unsigned char* base = vt + dl * VPITCH + 8 * h;
#pragma unroll
    for (int db = 0; db < 4; ++db) {
        bf16x8 a[4];
#pragma unroll
        for (int kk = 0; kk < 4; ++kk) {
            const unsigned char* p = base + db * 32 * VPITCH + kk * 32;
            const s16x4 lo = *(const s16x4*)p, hi = *(const s16x4*)(p + 16);
            a[kk] = __builtin_shufflevector(lo, hi, 0, 1, 2, 3, 4, 5, 6, 7);
        }
#pragma unroll
        for (int kk = 0; kk < 4; ++kk) o[db] = MFMA32(a[kk], pf[kk], o[db]);
        __builtin_amdgcn_sched_barrier(0);
    }
}
DI void qk_half(const unsigned char* kt, int kb, const bf16x8 (&qf)[8], f32x16& s1, int lane) {
    const int key = lane & 31, h = lane >> 5;
    const unsigned char* base = kt + (kb * 32 + key) * KPITCH + h * 16;
#pragma unroll
    for (int i = 0; i < 16; ++i) s1[i] = 0.f;
#pragma unroll
    for (int kg = 0; kg < 2; ++kg) {
        bf16x8 a[4];
#pragma unroll
        for (int q = 0; q < 4; ++q) a[q] = *(const bf16x8*)(base + (kg * 4 + q) * 32);
#pragma unroll
        for (int q = 0; q < 4; ++q) s1 = MFMA32(a[q], qf[kg * 4 + q], s1);
    }
}
DI void pv_half(const unsigned char* vt, int kb, const bf16x8 (&pf)[2], f32x16 (&o)[4], int lane) {
    const int dl = lane & 31, h = lane >> 5;
    const unsigned char* base = vt + dl * VPITCH + 8 * h + kb * 64;
#pragma unroll
    for (int dp = 0; dp < 2; ++dp) {
        bf16x8 a[4];
#pragma unroll
        for (int q = 0; q < 4; ++q) {
            const unsigned char* p = base + (dp * 2 + (q >> 1)) * 32 * VPITCH + (q & 1) * 32;
            const s16x4 lo = *(const s16x4*)p, hi = *(const s16x4*)(p + 16);
            a[q] = __builtin_shufflevector(lo, hi, 0, 1, 2, 3, 4, 5, 6, 7);
        }
#pragma unroll
        for (int q = 0; q < 4; ++q) o[dp * 2 + (q >> 1)] = MFMA32(a[q], pf[q & 1], o[dp * 2 + (q >> 1)]);
    }
}
DI void pack_half(const f32x16& s1, bf16x8 (&pf)[2]) {
#pragma unroll
    for (int ss = 0; ss < 2; ++ss) {
        u32x4 w; w.x = pk2(s1[8 * ss + 0], s1[8 * ss + 1]); w.y = pk2(s1[8 * ss + 2], s1[8 * ss + 3]); w.z = pk2(s1[8 * ss + 4], s1[8 * ss + 5]); w.w = pk2(s1[8 * ss + 6], s1[8 * ss + 7]);
        pf[ss] = __builtin_bit_cast(bf16x8, w);
    }
}
DI void pack_p(const f32x16 (&s)[2], bf16x8 (&pf)[4]) {
#pragma unroll
    for (int kb = 0; kb < 2; ++kb)
#pragma unroll
        for (int ss = 0; ss < 2; ++ss) {
            u32x4 w; w.x = pk2(s[kb][8 * ss + 0], s[kb][8 * ss + 1]); w.y = pk2(s[kb][8 * ss + 2], s[kb][8 * ss + 3]); w.z = pk2(s[kb][8 * ss + 4], s[kb][8 * ss + 5]); w.w = pk2(s[kb][8 * ss + 6], s[kb][8 * ss + 7]);
            pf[kb * 2 + ss] = __builtin_bit_cast(bf16x8, w);
        }
}
DI void store_o(bf16_t* orow, const f32x16 (&o)[4], int lane) {
    const int h = lane >> 5;
#pragma unroll
    for (int db = 0; db < 4; ++db)
#pragma unroll
        for (int g4 = 0; g4 < 4; ++g4) {
            u32x2 w; w.x = pk2(o[db][4 * g4 + 0], o[db][4 * g4 + 1]); w.y = pk2(o[db][4 * g4 + 2], o[db][4 * g4 + 3]);
            *(u32x2*)(orow + db * 32 + g4 * 8 + 4 * h) = w;
        }
}

DI void sb_item(unsigned char* ws, unsigned char* lds, int b, int hh, int qblk, bf16_t* outb) {
    const int tid = threadIdx.x, lane = tid & 63, wave = __builtin_amdgcn_readfirstlane(tid >> 6), col = lane & 31, h = lane >> 5;
    const int t = qblk * 256 + wave * 32 + col;
    const bf16_t* qrow = (const bf16_t*)(ws + WS_QSB) + ((size_t)(b * S_ + t)) * 1024 + hh * 128;
    bf16x8 qf[8];
#pragma unroll
    for (int ks = 0; ks < 8; ++ks) qf[ks] = __builtin_nontemporal_load((const bf16x8*)(qrow + ks * 16 + h * 8));
    f32x16 o[4];
#pragma unroll
    for (int db = 0; db < 4; ++db)
#pragma unroll
        for (int i = 0; i < 16; ++i) o[db][i] = 0.f;
    float R = 0.f;
    const bf16_t* Kb = (const bf16_t*)(ws + WS_KSB) + ((size_t)b * S_) * 1024 + hh * 128;
    const bf16_t* Vb = (const bf16_t*)(ws + WS_VTSB) + ((size_t)(b * 8 + hh) * 128) * S_;
    const int nt = qblk * 4 + 4;
    const int wmax = (qblk * 256 + wave * 32 + 30) >> 6;
    KVRegs Rg;
    kv_load<true, true>(Rg, Kb + (size_t)((nt - 1) * 64) * 1024, 1024, Vb + (nt - 1) * 64, S_, tid);
    kv_store(Rg, lds, tid);
    __syncthreads();
    for (int it = 0; it < nt; ++it) {
        const int kt = nt - 1 - it, cur = it & 1;
        if (it + 1 < nt) kv_load<true, true>(Rg, Kb + (size_t)((kt - 1) * 64) * 1024, 1024, Vb + (kt - 1) * 64, S_, tid);
        if (kt <= wmax) {
            const unsigned char* buf = lds + cur * TILE_BYTES;
            f32x16 s[2], lm[2];
            qk_tile(buf, qf, s, lane);
            const int key0 = kt * 64;
#pragma unroll
            for (int kb = 0; kb < 2; ++kb)
#pragma unroll
                for (int i = 0; i < 16; ++i) {
                    const int kpos = key0 + 32 * kb + 8 * (i >> 2) + 4 * h + (i & 3);
                    const float z = s[kb][i] * QSCALE;
                    const float sp = __logf(1.0f + __expf(-fabsf(z)));
                    const bool valid = kpos < t;
                    s[kb][i] = valid ? z : 0.f;
                    lm[kb][i] = valid ? -(fmaxf(z, 0.f) + sp) : 0.f;
                }
            float own[8], par[8], sufg[8];
#pragma unroll
            for (int m = 0; m < 8; ++m) { const int kb = m >> 2, g4 = m & 3; own[m] = (lm[kb][4 * g4] + lm[kb][4 * g4 + 1]) + (lm[kb][4 * g4 + 2] + lm[kb][4 * g4 + 3]); }
#pragma unroll
            for (int m = 0; m < 8; ++m) par[m] = __shfl_xor(own[m], 32);
            float Tt = 0.f;
#pragma unroll
            for (int m = 7; m >= 0; --m) { sufg[m] = Tt + (h == 0 ? par[m] : 0.f); Tt += own[m] + par[m]; }
#pragma unroll
            for (int kb = 0; kb < 2; ++kb)
#pragma unroll
                for (int g4 = 0; g4 < 4; ++g4) {
                    float run = R + sufg[kb * 4 + g4];
#pragma unroll
                    for (int i = 3; i >= 0; --i) {
                        const int idx = 4 * g4 + i;
                        const int kpos = key0 + 32 * kb + 8 * g4 + 4 * h + i;
                        const float l1 = lm[kb][idx];
                        const float lb = l1 + s[kb][idx];
                        const float w = (kpos < t) ? __expf(lb + run) : 0.f;
                        run += l1;
                        s[kb][idx] = w;
                    }
                }
            R += Tt;
            bf16x8 pf[4];
            pack_p(s, pf);
            pv_tile(buf + KBYTES, pf, o, lane);
        }
        if (it + 1 < nt) kv_store(Rg, lds + (cur ^ 1) * TILE_BYTES, tid);
        const int wdone = (kt <= wmax) && __all(R < -104.0f);
        if (__syncthreads_and(wdone)) break;
    }
    store_o(outb + ((size_t)(b * S_ + t)) * 1024 + hh * 128, o, lane);
}

constexpr int SC_PITCH = 65;
constexpr int NSA_SCA = 2 * TILE_BYTES, NSA_SCB = NSA_SCA + 64 * SC_PITCH * 4, NSA_UNI = NSA_SCB + 64 * SC_PITCH * 4, NSA_SEL = NSA_UNI + 16, NSA_STASH = NSA_SEL + 64 * 8, NSA_END = NSA_STASH + 512 * 8;
static_assert(NSA_END <= LDS_BYTES, "LDS");
template <int MK, int OP, bool PRE, int NXT> DI void nsa_branch(unsigned long long tiles, const bf16_t* Kp, unsigned kpitch, const bf16_t* Vp, unsigned vpitch, unsigned char* lds,
                                       const bf16x8 (&qf)[8], int t, int qb, float slope2, float& m, float& l, f32x16 (&o)[4], float pscale, unsigned mlo, unsigned mhi, int qloc, int r,
                                       int& cur, const bf16_t* nxtK, unsigned nxtkp, const bf16_t* nxtV, unsigned nxtvp, int nxt_tile) {
    const int tid = threadIdx.x, lane = tid & 63, h = lane >> 5;
    const float sc2 = QSCALE * LOG2E;
    unsigned tlo = __builtin_amdgcn_readfirstlane((unsigned)tiles), thi = __builtin_amdgcn_readfirstlane((unsigned)(tiles >> 32));
    unsigned long long tl = ((unsigned long long)thi << 32) | tlo;
    int j;
    if (MK == 0) { j = __builtin_ctzll(tl); tl &= tl - 1; } else { j = 63 - __builtin_clzll(tl); tl &= ~(1ull << j); }
    KVRegs Rg;
    if (!PRE) {
        kv_load<(OP >= 2)>(Rg, Kp + (size_t)(j * 64) * kpitch, kpitch, Vp + j * 64, vpitch, tid);
        kv_store<(OP >= 2)>(Rg, lds + cur * TILE_BYTES, tid);
        __syncthreads();
    }
    for (;;) {
        int jn = -1;
        if (tl != 0ull) {
            if (MK == 0) { jn = __builtin_ctzll(tl); tl &= tl - 1; } else { jn = 63 - __builtin_clzll(tl); tl &= ~(1ull << jn); }
            kv_load<(OP >= 2)>(Rg, Kp + (size_t)(jn * 64) * kpitch, kpitch, Vp + jn * 64, vpitch, tid);
        } else if (NXT != 0) {
            kv_load<(NXT == 2)>(Rg, nxtK + (size_t)(nxt_tile * 64) * nxtkp, nxtkp, nxtV + nxt_tile * 64, nxtvp, tid);
        }
        const unsigned char* buf = lds + cur * TILE_BYTES;
        const int key0 = j * 64;
        const bool selbit = (MK == 1) ? (((j < 32 ? (mlo >> j) : (mhi >> (j - 32))) & 1u) != 0u) : true;
        const bool bnd = (MK == 0) ? true : ((MK == 1) ? (j == qb) : (j == qb || j == qb - 8));
        int dbase = (MK == 0) ? (t - 31 - 16 * (key0 + 4 * h)) : (t - key0 - 4 * h);
        asm volatile("" : "+v"(dbase));
        const float fbase = (float)dbase;
        float B0 = -slope2 * fbase;
        if (MK == 1 && !selbit) B0 = -1e30f;
        const bool wave_skip = (MK == 1) && !bnd && !__any(selbit);
        if (!wave_skip)
#pragma unroll
        for (int kb = 0; kb < 2; ++kb) {
            f32x16 s1;
            qk_half(buf, kb, qf, s1, lane);
            float tm = -1e30f;
            if (bnd) {
#pragma unroll
                for (int i = 0; i < 16; ++i) {
                    const int e = 32 * kb + 8 * (i >> 2) + (i & 3);
                    const int dstep = (MK == 0) ? 16 : 1;
                    const int dist = dbase - dstep * e;
                    bool valid;
                    if (MK == 2) valid = (dist >= 0) && (dist < 512); else valid = dist >= 0;
                    const float v = valid ? __builtin_fmaf(s1[i], sc2, __builtin_fmaf(slope2, (float)(dstep * e), B0)) : -1e30f;
                    s1[i] = v;
                    tm = fmaxf(tm, v);
                }
            } else {
#pragma unroll
                for (int i = 0; i < 16; ++i) {
                    const int e = 32 * kb + 8 * (i >> 2) + (i & 3);
                    const float v = __builtin_fmaf(s1[i], sc2, __builtin_fmaf(slope2, (float)e, B0));
                    s1[i] = v;
                    tm = fmaxf(tm, v);
                }
            }
            if (OP == 1) {
                float A[4], Bv[4];
#pragma unroll
                for (int i = 0; i < 16; ++i) { const float v = s1[i]; s1[i] = (v > -1e29f) ? __builtin_amdgcn_exp2f(v - m) * l : 0.f; }
#pragma unroll
                for (int g4 = 0; g4 < 4; ++g4) { A[g4] = s1[4 * g4] + 2.0f * ((s1[4 * g4 + 1] + s1[4 * g4 + 2]) + s1[4 * g4 + 3]); Bv[g4] = s1[4 * g4]; }
#pragma unroll
                for (int g4 = 0; g4 < 4; ++g4) { A[g4] += __shfl_xor(A[g4], 8); A[g4] += __shfl_xor(A[g4], 16); Bv[g4] += __shfl_xor(Bv[g4], 8); Bv[g4] += __shfl_xor(Bv[g4], 16); }
                float* scA = (float*)(lds + NSA_SCA); float* scB = (float*)(lds + NSA_SCB);
#pragma unroll
                for (int g4 = 0; g4 < 4; ++g4) {
                    const int jj = j * 16 + kb * 8 + 2 * g4 + h;
                    if (r == 0) scA[qloc * SC_PITCH + jj] = A[g4];
                    if (r == 1 && jj >= 1) scB[qloc * SC_PITCH + jj - 1] = Bv[g4];
                }
            } else if (OP == 3) {
                if (MK == 0) {
#pragma unroll
                    for (int i = 0; i < 16; ++i) { const float v = s1[i]; s1[i] = (v > -1e29f) ? __builtin_amdgcn_exp2f(v - m) * pscale : 0.f; }
                } else {
#pragma unroll
                    for (int i = 0; i < 16; ++i) s1[i] = __builtin_amdgcn_exp2f(s1[i] - m) * pscale;
                }
                bf16x8 pf[2];
                pack_half(s1, pf);
                pv_half(buf + KBYTES, kb, pf, o, lane);
            } else {
                tm = fmaxf(tm, __shfl_xor(tm, 32));
                const float mn = fmaxf(m, tm);
                const float alpha = __builtin_amdgcn_exp2f(m - mn);
                float ps = 0.f;
                if (MK == 0) {
#pragma unroll
                    for (int i = 0; i < 16; ++i) { const float v = s1[i]; const float p = (v > -1e29f) ? __builtin_amdgcn_exp2f(v - mn) : 0.f; s1[i] = p; ps += p; }
                } else {
#pragma unroll
                    for (int i = 0; i < 16; ++i) { const float p = __builtin_amdgcn_exp2f(s1[i] - mn); s1[i] = p; ps += p; }
                }
                l = l * alpha + ps;
                m = mn;
                if (OP == 2) {
                    if (!__all(alpha == 1.0f)) {
#pragma unroll
                        for (int db = 0; db < 4; ++db)
#pragma unroll
                            for (int i = 0; i < 16; ++i) o[db][i] *= alpha;
                    }
                    bf16x8 pf[2];
                    pack_half(s1, pf);
                    pv_half(buf + KBYTES, kb, pf, o, lane);
                }
            }
        }
        if (jn >= 0) kv_store<(OP >= 2)>(Rg, lds + (cur ^ 1) * TILE_BYTES, tid);
        else if (NXT != 0) kv_store<(NXT == 2)>(Rg, lds + (cur ^ 1) * TILE_BYTES, tid);
        __syncthreads();
        if (jn < 0) break;
        j = jn; cur ^= 1;
    }
    if (NXT != 0) cur ^= 1;
}

DI void nsa_item(unsigned char* ws, unsigned char* lds, int b, int g, int qb, bf16_t* outb) {
    const int tid = threadIdx.x, lane = tid & 63, wave = __builtin_amdgcn_readfirstlane(tid >> 6), col = lane & 31, h = lane >> 5;
    const int r = col >> 3, qi = col & 7, qloc = wave * 8 + qi;
    const int t = qb * 64 + qloc, head = g * 4 + r;
    const float slope2 = exp2f(-(float)(head + 1)) * LOG2E;
    const bf16_t* qrow = (const bf16_t*)(ws + WS_QNSA) + ((size_t)(b * S_ + t)) * 1024 + head * 128;
    bf16x8 qf[8];
#pragma unroll
    for (int ks = 0; ks < 8; ++ks) qf[ks] = __builtin_nontemporal_load((const bf16x8*)(qrow + ks * 16 + h * 8));
    float* stash = (float*)(lds + NSA_STASH) + tid * 2;
    float* scA = (float*)(lds + NSA_SCA); float* scB = (float*)(lds + NSA_SCB);
    unsigned* selm = (unsigned*)(lds + NSA_SEL); unsigned* uni = (unsigned*)(lds + NSA_UNI);
    for (int i = tid; i < 2 * 64 * SC_PITCH + 4; i += NTHREADS) scA[i] = 0.f;
    __syncthreads();
    f32x16 o[4];
#pragma unroll
    for (int db = 0; db < 4; ++db)
#pragma unroll
        for (int i = 0; i < 16; ++i) o[db][i] = 0.f;
#define NSA_KS ((const bf16_t*)(ws + WS_KSLC) + ((size_t)b * S_) * 256 + g * 128)
#define NSA_VS ((const bf16_t*)(ws + WS_VTSLC) + ((size_t)(b * 2 + g) * 128) * S_)
#define NSA_KW ((const bf16_t*)(ws + WS_KWIN) + ((size_t)b * S_) * 256 + g * 128)
#define NSA_VW ((const bf16_t*)(ws + WS_VTWIN) + ((size_t)(b * 2 + g) * 128) * S_)
#define NSA_KC ((const bf16_t*)(ws + WS_KC) + ((size_t)(b * 2 + g) * 256) * 128)
#define NSA_VC ((const bf16_t*)(ws + WS_VCT) + ((size_t)(b * 2 + g) * 128) * 256)
    int cur = 0;
    const int ntc = ((4 * qb + 2) >> 6) + 1;
    const unsigned long long ctiles = (1ull << ntc) - 1ull;
    {
        float m_c = -1e30f, inv_c = 0.f;
        float l = 0.f;
        nsa_branch<0, 0, false, 1>(ctiles, NSA_KC, 128, NSA_VC, 256, lds, qf, t, qb, slope2, m_c, l, o, 0.f, 0u, 0u, qloc, r, cur, NSA_KC, 128, NSA_VC, 256, 0);
        l += __shfl_xor(l, 32);
        inv_c = (l > 0.f) ? 1.0f / l : 0.f;
        nsa_branch<0, 1, true, 2>(ctiles, NSA_KC, 128, NSA_VC, 256, lds, qf, t, qb, slope2, m_c, inv_c, o, 0.f, 0u, 0u, qloc, r, cur, NSA_KS, 256, NSA_VS, S_, qb);
        stash[0] = m_c; stash[1] = inv_c;
    }
    {
        const int qq = tid >> 3, sub = tid & 7;
        float cand[8];
#pragma unroll
        for (int k = 0; k < 8; ++k) {
            const int jj = sub * 8 + k;
            float v = scA[qq * SC_PITCH + jj] + scB[qq * SC_PITCH + jj];
            if (jj == 0 || jj == qb || jj == qb - 1) v = 1e9f;
            if (jj > qb) v = -1e30f;
            cand[k] = v;
        }
        __syncthreads();
#pragma unroll
        for (int k = 0; k < 8; ++k) scA[qq * SC_PITCH + sub * 8 + k] = cand[k];
        __syncthreads();
        int cnt[8];
#pragma unroll
        for (int k = 0; k < 8; ++k) cnt[k] = 0;
        for (int jp = 0; jp < 64; ++jp) {
            const float v = scA[qq * SC_PITCH + jp];
#pragma unroll
            for (int k = 0; k < 8; ++k) { const int jj = sub * 8 + k; cnt[k] += ((v > cand[k]) || (v == cand[k] && jp < jj)) ? 1 : 0; }
        }
        unsigned bits = 0u;
#pragma unroll
        for (int k = 0; k < 8; ++k) if (cnt[k] < 16 && (sub * 8 + k) <= qb) bits |= (1u << k);
        unsigned lo = (sub < 4) ? (bits << (8 * sub)) : 0u, hi = (sub >= 4) ? (bits << (8 * (sub - 4))) : 0u;
        lo |= __shfl_xor(lo, 1); lo |= __shfl_xor(lo, 2); lo |= __shfl_xor(lo, 4);
        hi |= __shfl_xor(hi, 1); hi |= __shfl_xor(hi, 2); hi |= __shfl_xor(hi, 4);
        if (sub == 0) { selm[qq * 2] = lo; selm[qq * 2 + 1] = hi; atomicOr(&uni[0], lo); atomicOr(&uni[1], hi); }
        __syncthreads();
    }
    {
        const unsigned mlo = selm[qloc * 2], mhi = selm[qloc * 2 + 1];
        const unsigned long long un = ((unsigned long long)uni[1] << 32) | uni[0];
        float m = -1e30f, l = 0.f;
        nsa_branch<1, 2, true, 2>(un, NSA_KS, 256, NSA_VS, S_, lds, qf, t, qb, slope2, m, l, o, 0.f, mlo, mhi, qloc, r, cur, NSA_KC, 128, NSA_VC, 256, 0);
        l += __shfl_xor(l, 32);
        const float g_s = ((const float*)(ws + WS_GN))[(b * S_ + t) * 32 + 8 + g * 4 + ((lane & 31) >> 3)]; const float f = (l > 0.f) ? g_s / l : 0.f;
#pragma unroll
        for (int db = 0; db < 4; ++db)
#pragma unroll
            for (int i = 0; i < 16; ++i) o[db][i] *= f;
    }
    {
        float mm = stash[0], ll = 0.f;
        const float g_c = ((const float*)(ws + WS_GN))[(b * S_ + t) * 32 + g * 4 + ((lane & 31) >> 3)];
        nsa_branch<0, 3, true, 1>(ctiles, NSA_KC, 128, NSA_VC, 256, lds, qf, t, qb, slope2, mm, ll, o, stash[1] * g_c, 0u, 0u, qloc, r, cur, NSA_KW, 256, NSA_VW, S_, qb);
    }
    {
        const int lo_t = qb >= 8 ? qb - 8 : 0;
        const unsigned long long tiles = ((qb == 63) ? ~0ull : ((1ull << (qb + 1)) - 1ull)) & ~((1ull << lo_t) - 1ull);
        float m = -1e30f, l = 0.f;
        nsa_branch<2, 0, true, 2>(tiles, NSA_KW, 256, NSA_VW, S_, lds, qf, t, qb, slope2, m, l, o, 0.f, 0u, 0u, qloc, r, cur, NSA_KW, 256, NSA_VW, S_, qb);
        l += __shfl_xor(l, 32);
        const float g_w = ((const float*)(ws + WS_GN))[(b * S_ + t) * 32 + 16 + g * 4 + ((lane & 31) >> 3)]; const float f = (l > 0.f) ? g_w / l : 0.f;
        nsa_branch<2, 3, true, 0>(tiles, NSA_KW, 256, NSA_VW, S_, lds, qf, t, qb, slope2, m, l, o, f, 0u, 0u, qloc, r, cur, NSA_KW, 256, NSA_VW, S_, qb);
    }
    {
        int tid2 = threadIdx.x; asm volatile("" : "+v"(tid2));
        const int col2 = tid2 & 31, t2 = qb * 64 + (tid2 >> 6) * 8 + (col2 & 7), head2 = g * 4 + (col2 >> 3);
        store_o(outb + ((size_t)(b * S_ + t2)) * 1024 + head2 * 128, o, tid2 & 63);
    }
}
}

using mk::Params;
__global__ void __launch_bounds__(512, 2) mega_fwd(Params p) {
    extern __shared__ __attribute__((aligned(16))) unsigned char lds[];
    cg::grid_group grid = cg::this_grid();
    using namespace mk;
    const int G = gridDim.x, bid = blockIdx.x;
    PG8_LAS unsigned char* l3 = (PG8_LAS unsigned char*)lds;
    unsigned char* ws = p.ws;
#define IN(k) ((p.phmask >> (k)) & 1u)
#ifndef SKIPMASK
#define SKIPMASK 0
#endif
#define SKIP(k) ((SKIPMASK >> (k)) & 1)
#define SEAM(k) do { } while (0)
    if (threadIdx.x < 4) ((unsigned*)(lds + 131072))[threadIdx.x] = 0u;
    __syncthreads();
    XcdBarrier xbar = xcd_barrier_post((unsigned*)(ws + WS_BAR), (volatile XB_LAS unsigned*)(lds + 131072));
    if (p.pad == 0x5eedu) grid.sync();
    bf16_t* const Hb = (bf16_t*)(ws + WS_H);
    float* const Yb = (float*)(ws + WS_Y);
    bf16_t* const ACT = (bf16_t*)(ws + WS_ACT);

    if (IN(0) && !SKIP(0)) {
        convert_w<1>(p.f1_w_in, D_, 2 * FF_, (bf16_t*)(ws + WS_WFIN), D_, 2 * FF_, (unsigned*)lds, bid, G);
        convert_w<0>(p.f1_w_out, FF_, D_, (bf16_t*)(ws + WS_WFOUT), FF_, D_, (unsigned*)lds, bid, G);
        convert_w<2>(p.w_in, D_, 9752, (bf16_t*)(ws + WS_WIN), D_, NVIN, (unsigned*)lds, bid, G, p.mix_pre_g);
        convert_w<0>(p.cmp_k_w1, 4096, 128, (bf16_t*)(ws + WS_WC1K), 4096, 256, (unsigned*)lds, bid, G);
        convert_w<0>(p.cmp_v_w1, 4096, 128, (bf16_t*)(ws + WS_WC1V), 4096, 256, (unsigned*)lds, bid, G);
        convert_w<0>(p.cmp_k_w2, 128, 128, (bf16_t*)(ws + WS_WC2K), 256, 256, (unsigned*)lds, bid, G);
        convert_w<0>(p.cmp_v_w2, 128, 128, (bf16_t*)(ws + WS_WC2V), 256, 256, (unsigned*)lds, bid, G);
        if (bid >= G - 16) cmp_bias_part(p.cmp_pos_k, p.cmp_k_w1, (float*)(ws + WS_BIAS), G - 1 - bid, (float*)lds);
        else if (bid >= G - 32) cmp_bias_part(p.cmp_pos_v, p.cmp_v_w1, (float*)(ws + WS_BIAS) + 2048, G - 17 - bid, (float*)lds);
        rowwise<0>(p.x, nullptr, nullptr, Hb, nullptr, p.f1_pre_g, 1.0f, bid, G);
    }
    xcd_barrier(xbar);
    if (IN(1) && !SKIP(1)) {
        pg8::Gemm g{Hb, (const bf16_t*)(ws + WS_WFIN), T_, 2 * FF_, D_, D_}; pg8::StaticOrder S; S.init(T_, 2 * FF_, G, bid);
        EpiSwiglu E{ACT, nullptr};
        pg8::gemm_phase<EpiSwiglu, pg8::StaticOrder, true, true>(l3, g, S, E);
    }
    xcd_barrier(xbar);
    if (IN(2) && !SKIP(2)) {
        pg8::Gemm g{ACT, (const bf16_t*)(ws + WS_WFOUT), T_, D_, FF_, FF_}; pg8::StaticOrder S; S.init(T_, D_, G, bid);
        pg8::EpiBf16<0> E{(bf16_t*)Yb, D_, nullptr, 0, 0};
        pg8::gemm_phase<pg8::EpiBf16<0>, pg8::StaticOrder, true, true>(l3, g, S, E);
    }
    xcd_barrier(xbar);
    if (IN(3) && !SKIP(3)) {
        rowwise<1, false, true, true>(Yb, p.x, p.out, (bf16_t*)(ws + WS_RS2), p.f1_post_g, p.mix_pre_g, 0.5f, bid, G);
        convert_w<1>(p.f2_w_in, D_, 2 * FF_, (bf16_t*)(ws + WS_WFIN), D_, 2 * FF_, (unsigned*)lds, bid, G, p.f2_pre_g, 1088, -1);
    }
    xcd_barrier(xbar);
    if (IN(4) && !SKIP(4)) {
        {
            pg8::Gemm g{(const bf16_t*)p.out, (const bf16_t*)(ws + WS_WIN), T_, 8448, D_, D_}; pg8::StaticOrder S; S.init(T_, 8448, G, bid);
            EpiInprojA E{ws, (const float*)(ws + WS_RS2)};
            pg8::gemm_phase<EpiInprojA, pg8::StaticOrder, true, true>(l3, g, S, E);
        }
        {
            pg8::Gemm g{(const bf16_t*)p.out, (const bf16_t*)(ws + WS_WIN) + (size_t)8448 * D_, T_, 1536, D_, D_}; pg8::StaticOrder S; S.init(T_, 1536, G, (bid + G - 64) % G);
            EpiInprojB E{ws, (const float*)(ws + WS_RS2)};
            pg8::gemm_phase<EpiInprojB, pg8::StaticOrder, true, true>(l3, g, S, E);
        }
        if (bid >= G - 64) convert_w<1>(p.f2_w_in, D_, 2 * FF_, (bf16_t*)(ws + WS_WFIN), D_, 2 * FF_, (unsigned*)lds, bid - (G - 64), 64, p.f2_pre_g, 0, 1088);
    }
    xcd_barrier(xbar);
    if (IN(5) && !SKIP(5)) {
#pragma unroll 1
        for (int ci = 0; ci < 8; ++ci) {
            const bf16_t* Ab = (const bf16_t*)(ws + ((ci >> 2) ? WS_KCV : WS_KCK)) + (ci & 3) * 1024;
            const bf16_t* Bb = (const bf16_t*)(ws + ((ci >> 2) ? WS_WC1V : WS_WC1K)) + (ci & 3) * 1024;
            if (bid >= 8 * ci && bid < 8 * ci + 8) {
                pg8::Gemm g{Ab, Bb, 2048, 256, 1024, 2048}; pg8::StaticOrder S; S.init(2048, 256, G, bid - 8 * ci);
                g.ldb = 4096;
                EpiPart E{(float*)(ws + WS_CPART) + (size_t)ci * 2048 * 128};
                pg8::gemm_phase<EpiPart, pg8::StaticOrder, true, true>(l3, g, S, E);
            }
        }
        __syncthreads();
        for (int k = 0;; ++k) {
            const int idx = (k & 1) ? (k + 1) * G - 1 - bid : k * G + bid;
            if (k * G >= 512) break;
            if (idx >= 512 || idx < 0) continue;
            const int qblk = 15 - (idx >> 5), bh = idx & 31;
            sb_item(ws, lds, bh >> 3, bh & 7, qblk, (bf16_t*)(ws + WS_QSB));
        }
        if (bid >= 64) {
            convert_w<0>(p.w_branch_sb, 1024, D_, (bf16_t*)(ws + WS_WSB), 1024, D_, (unsigned*)lds, bid - 64, G - 64);
            convert_w<0>(p.w_branch_nsa, 1024, D_, (bf16_t*)(ws + WS_WNSA), 1024, D_, (unsigned*)lds, bid - 64, G - 64);
            convert_w<0>(p.w_out, D_, D_, (bf16_t*)(ws + WS_WOUT), D_, D_, (unsigned*)lds, bid - 64, G - 64);
        }
    }
    xcd_barrier(xbar);
    if (IN(6) && !SKIP(6)) {
        if (bid < 8) {
            pg8::StaticOrder S; S.init(2048, 256, G, bid);
            cmp_g1_tile((const float*)(ws + WS_CPART), (const float*)(ws + WS_BIAS), (bf16_t*)(ws + WS_G1K), bid);
            asm volatile("s_waitcnt vmcnt(0)" ::: "memory"); __syncthreads();
            pg8::Gemm g{(const bf16_t*)(ws + WS_G1K), (const bf16_t*)(ws + WS_WC2K), 2048, 256, 256, 256}; g.ldb = 256;
            EpiCmp2<0> E{(bf16_t*)(ws + WS_KC)};
            pg8::gemm_phase<EpiCmp2<0>, pg8::StaticOrder, true, true>(l3, g, S, E);
        } else if (bid < 16) {
            pg8::StaticOrder S; S.init(2048, 256, G, bid - 8);
            cmp_g1_tile((const float*)(ws + WS_CPART) + (size_t)4 * 2048 * 128, (const float*)(ws + WS_BIAS) + 2048, (bf16_t*)(ws + WS_G1V), bid - 8);
            asm volatile("s_waitcnt vmcnt(0)" ::: "memory"); __syncthreads();
            pg8::Gemm g{(const bf16_t*)(ws + WS_G1V), (const bf16_t*)(ws + WS_WC2V), 2048, 256, 256, 256}; g.ldb = 256;
            EpiCmp2<1> E{(bf16_t*)(ws + WS_VCT)};
            pg8::gemm_phase<EpiCmp2<1>, pg8::StaticOrder, true, true>(l3, g, S, E);
        }
        if (bid >= 16) convert_w<0>(p.f2_w_out, FF_, D_, (bf16_t*)(ws + WS_WFOUT), FF_, D_, (unsigned*)lds, bid - 16, G - 16);
    }
    xcd_barrier(xbar);
    if (IN(7) && !SKIP(7)) {
        for (int k = 0;; ++k) {
            const int idx = (k & 1) ? (k + 1) * G - 1 - bid : k * G + bid;
            if (k * G >= 512) break;
            if (idx >= 512 || idx < 0) continue;
            const int qb = 63 - (idx >> 3), bg = idx & 7;
            nsa_item(ws, lds, bg >> 1, bg & 1, qb, (bf16_t*)(ws + WS_QNSA));
        }
    }
    xcd_barrier(xbar);
    if (IN(8) && !SKIP(8)) {
        {
            pg8::Gemm g{(const bf16_t*)(ws + WS_QSB), (const bf16_t*)(ws + WS_WSB), T_, D_, 1024, 1024}; pg8::StaticOrder S; S.init(T_, D_, G, bid);
            EpiBranch<0> E{Hb, (const bf16_t*)(ws + WS_Y)};
            pg8::gemm_phase<EpiBranch<0>, pg8::StaticOrder, true, true>(l3, g, S, E);
        }
        {
            pg8::Gemm g{(const bf16_t*)(ws + WS_QNSA), (const bf16_t*)(ws + WS_WNSA), T_, D_, 1024, 1024}; pg8::StaticOrder S; S.init(T_, D_, G, bid);
            EpiBranch<1> E{Hb, (const bf16_t*)(ws + WS_Y)};
            pg8::gemm_phase<EpiBranch<1>, pg8::StaticOrder, true, true>(l3, g, S, E);
        }
    }
    xcd_barrier(xbar);
    if (IN(9) && !SKIP(9)) {
        pg8::Gemm g{Hb, (const bf16_t*)(ws + WS_WOUT), T_, D_, D_, D_}; pg8::StaticOrder S; S.init(T_, D_, G, bid);
        pg8::EpiBf16<0> E{(bf16_t*)Yb, D_, nullptr, 0, 0};
        pg8::gemm_phase<pg8::EpiBf16<0>, pg8::StaticOrder, true, true>(l3, g, S, E);
    }
    xcd_barrier(xbar);
    if (IN(10) && !SKIP(10)) rowwise<1, true, true, true>(Yb, p.out, (bf16_t*)(ws + WS_Y) + (size_t)T_ * D_, (bf16_t*)(ws + WS_RS3), p.mix_post_g, p.f2_pre_g, 1.0f, bid, G);
    xcd_barrier(xbar);
    if (IN(11) && !SKIP(11)) {
        pg8::Gemm g{(const bf16_t*)(ws + WS_Y) + (size_t)T_ * D_, (const bf16_t*)(ws + WS_WFIN), T_, 2 * FF_, D_, D_}; pg8::StaticOrder S; S.init(T_, 2 * FF_, G, bid);
        EpiSwigluT<true> E{ACT, (const float*)(ws + WS_RS3)};
        pg8::gemm_phase<EpiSwigluT<true>, pg8::StaticOrder, true, true>(l3, g, S, E);
    }
    xcd_barrier(xbar);
    if (IN(12) && !SKIP(12)) {
        pg8::Gemm g{ACT, (const bf16_t*)(ws + WS_WFOUT), T_, D_, FF_, FF_}; pg8::StaticOrder S; S.init(T_, D_, G, bid);
        pg8::EpiBf16<0> E{(bf16_t*)Yb, D_, nullptr, 0, 0};
        pg8::gemm_phase<pg8::EpiBf16<0>, pg8::StaticOrder, true, true>(l3, g, S, E);
    }
    xcd_barrier(xbar);
    if (IN(13) && !SKIP(13)) rowwise<2, true, false>(Yb, (const bf16_t*)(ws + WS_Y) + (size_t)T_ * D_, p.out, nullptr, p.f2_post_g, nullptr, 0.5f, bid, G);
#undef IN
#undef SEAM
}

extern "C" void kernel_launch(void* const* d_in, const int* in_sizes, int n_in, void* d_out, int out_size, void* d_ws, size_t ws_size, hipStream_t stream) {
    static int grid = 0;
    if (grid == 0) {
        if (n_in != 21 || ws_size < mk::WS_END) { fprintf(stderr, "kernel_launch: unexpected n_in %d or ws_size %zu (need %zu)\n", n_in, ws_size, (size_t)mk::WS_END); grid = -1; return; }
        int dev = 0, cus = 0, per_cu = 0;
        hipGetDevice(&dev);
        hipDeviceGetAttribute(&cus, hipDeviceAttributeMultiprocessorCount, dev);
        if (hipFuncSetAttribute((const void*)mega_fwd, hipFuncAttributeMaxDynamicSharedMemorySize, mk::LDS_BYTES) != hipSuccess) { fprintf(stderr, "kernel_launch: hipFuncSetAttribute failed\n"); grid = -1; return; }
        if (hipOccupancyMaxActiveBlocksPerMultiprocessor(&per_cu, (const void*)mega_fwd, 512, mk::LDS_BYTES) != hipSuccess || per_cu < 1) { (void)hipGetLastError(); per_cu = 1; }
        grid = cus * per_cu;
        fprintf(stderr, "kernel_launch: grid %d (cus %d per_cu %d) ws %zu\n", grid, cus, per_cu, ws_size);
    }
    if (grid < 0) return;
    Params p{};
    const float** f = (const float**)&p;
    for (int i = 0; i < 21; ++i) f[i] = (const float*)d_in[i];
    p.out = (float*)d_out; p.ws = (unsigned char*)d_ws; p.phmask = 0x3fffu;
    if (hipMemsetAsync((char*)d_ws + mk::WS_BAR, 0, XCD_BAR_WORDS * 4, stream) != hipSuccess) { fprintf(stderr, "kernel_launch: memset of barrier words failed\n"); return; }
    void* args[] = {&p};
    hipError_t e = hipLaunchCooperativeKernel((const void*)mega_fwd, dim3(grid), dim3(512), args, mk::LDS_BYTES, stream);
    if (e != hipSuccess) fprintf(stderr, "cooperative launch failed: %s (grid %d)\n", hipGetErrorString(e), grid);
}
```
